# Optimizing an MI355X kernel written in HIP

```python
import math
import jax, jax.numpy as jnp
from jax import lax
import numpy as np

D_MODEL = 2048
BATCH = 8
SEQ = 4096
DEPTH = 4
DEC_BATCH = 32
DEC_SEQ = 16
PAST_LEN = 4096

CHUNK = 64
N_MIXERS = 2
N_S5 = (DEPTH + 1) // 2
N_SSD = DEPTH // 2
RMS_EPS = 1e-5
S5_GROUP = 16
S5_GROUPS = D_MODEL // S5_GROUP
S5_STATE = 64
SSD_INNER = 2 * D_MODEL
SSD_HEAD_DIM = 64
SSD_HEADS = SSD_INNER // SSD_HEAD_DIM
SSD_GROUPS = 8
SSD_HPG = SSD_HEADS // SSD_GROUPS
SSD_STATE = 128
SSD_CONV = 4
SSD_CONV_DIM = SSD_INNER + 2 * SSD_GROUPS * SSD_STATE
SSD_PROJ = SSD_INNER + SSD_CONV_DIM + SSD_HEADS
D_FF = 4 * D_MODEL

kernel_name = 'hybrid_s5_ssd_streaming_step'

F32 = jnp.float32


def rmsnorm(x, g):
    xf = x.astype(F32)
    y = xf * lax.rsqrt(jnp.mean(xf * xf, axis=-1, keepdims=True) + RMS_EPS)
    return (y * g.astype(F32)).astype(x.dtype)


def blockwise(step, carry, xs):
    t = xs[0].shape[1]
    if t <= CHUNK:
        return step(carry, xs)
    nb = t // CHUNK
    split = lambda a: jnp.moveaxis(a.reshape(a.shape[0], nb, CHUNK, *a.shape[2:]), 1, 0)
    carry, ys = lax.scan(step, carry, tuple(split(a) for a in xs))
    merge = lambda a: jnp.moveaxis(a, 0, 1).reshape(a.shape[1], t, *a.shape[3:])
    return carry, merge(ys)


def s5_mixer(u, h0, lam_re, lam_im, log_dt, b_re, b_im, c_re, c_im, d_skip, w_glu):
    bsz, t, _ = u.shape
    lam = lax.complex(lam_re.astype(F32), lam_im.astype(F32))
    dt = jnp.exp(log_dt.astype(F32))[:, None]
    lam_bar = jnp.exp(lam * dt)
    b = lax.complex(b_re.astype(F32), b_im.astype(F32))
    b_bar = ((lam_bar - 1.0) / lam)[..., None] * b
    c = lax.complex(c_re.astype(F32), c_im.astype(F32))
    uf = u.astype(F32)
    ug = uf.reshape(bsz, t, S5_GROUPS, S5_GROUP)

    def combine(left, right):
        a_l, b_l = left
        a_r, b_r = right
        return a_l * a_r, a_r * b_l + b_r

    def step(h, blk):
        ub = blk[0]
        bu = jnp.einsum('blgc,gpc->blgp', ub.astype(jnp.complex64), b_bar)
        bu = bu.at[:, 0].add(lam_bar * h)
        a = jnp.broadcast_to(lam_bar, bu.shape)
        _, hs = lax.associative_scan(combine, (a, bu), axis=1)
        y = jnp.real(jnp.einsum('blgp,gcp->blgc', hs, c))
        return hs[:, -1], y

    h_last, y = blockwise(step, h0, (ug,))
    y = y.reshape(bsz, t, D_MODEL) + d_skip.astype(F32) * uf
    g = jax.nn.gelu(y).astype(w_glu.dtype)
    ga, gb = jnp.split(g @ w_glu, 2, axis=-1)
    out = ga.astype(F32) * jax.nn.sigmoid(gb.astype(F32))
    return out, h_last


def ssd_mixer(u, conv_state, ssm_state, w_in, conv_w, conv_b, dt_bias, a_log, d_skip, norm_w, w_out):
    bsz, t, _ = u.shape
    zxbcdt = u @ w_in
    z, xbc, dt_raw = jnp.split(zxbcdt, [SSD_INNER, SSD_INNER + SSD_CONV_DIM], axis=-1)
    xpad = jnp.concatenate([conv_state.astype(F32), xbc.astype(F32)], axis=1)
    new_conv = xpad[:, -(SSD_CONV - 1):]
    cw = conv_w.astype(F32)
    xc = conv_b.astype(F32) + sum(xpad[:, k:k + t] * cw[k] for k in range(SSD_CONV))
    xc = jax.nn.silu(xc)
    xs, bm, cm = jnp.split(xc, [SSD_INNER, SSD_INNER + SSD_GROUPS * SSD_STATE], axis=-1)
    xs = xs.reshape(bsz, t, SSD_GROUPS, SSD_HPG, SSD_HEAD_DIM)
    bm = bm.reshape(bsz, t, SSD_GROUPS, SSD_STATE)
    cm = cm.reshape(bsz, t, SSD_GROUPS, SSD_STATE)
    dt = jax.nn.softplus(dt_raw.astype(F32) + dt_bias.astype(F32)).reshape(bsz, t, SSD_GROUPS, SSD_HPG)
    a = -jnp.exp(a_log.astype(F32)).reshape(SSD_GROUPS, SSD_HPG)
    h0 = ssm_state.astype(F32).reshape(bsz, SSD_GROUPS, SSD_HPG, SSD_HEAD_DIM, SSD_STATE)

    def step(h, blk):
        x_b, b_b, c_b, dt_b = blk
        l = x_b.shape[1]
        acum = jnp.cumsum(dt_b * a, axis=1)
        diff = acum[:, :, None] - acum[:, None, :]
        causal = jnp.tril(jnp.ones((l, l), dtype=bool))[None, :, :, None, None]
        decay = jnp.exp(jnp.where(causal, diff, -jnp.inf))
        cb = jnp.einsum('blgn,bsgn->blsg', c_b, b_b)
        w = cb[..., None] * decay * dt_b[:, None]
        y = jnp.einsum('blsgk,bsgkp->blgkp', w, x_b)
        y = y + jnp.einsum('blgn,bgkpn->blgkp', c_b, h) * jnp.exp(acum)[..., None]
        tail = jnp.exp(acum[:, -1:] - acum) * dt_b
        h_new = h * jnp.exp(acum[:, -1])[..., None, None] + jnp.einsum('bsgn,bsgk,bsgkp->bgkpn', b_b, tail, x_b)
        return h_new, y

    h_last, y = blockwise(step, h0, (xs, bm, cm, dt))
    y = y + d_skip.astype(F32).reshape(SSD_GROUPS, SSD_HPG)[..., None] * xs
    y = y.reshape(bsz, t, SSD_INNER) * jax.nn.silu(z.astype(F32))
    yg = y.reshape(bsz, t, SSD_GROUPS, SSD_INNER // SSD_GROUPS)
    yg = yg * lax.rsqrt(jnp.mean(yg * yg, axis=-1, keepdims=True) + RMS_EPS)
    y = yg.reshape(bsz, t, SSD_INNER) * norm_w.astype(F32)
    out = y.astype(w_out.dtype) @ w_out
    return out, new_conv, h_last.reshape(bsz, SSD_HEADS, SSD_HEAD_DIM, SSD_STATE)


def channel_mlp(h, w1, w2):
    a = jax.nn.relu(h @ w1)
    return (a * a) @ w2


def setup_inputs(seed: int = 0) -> dict:
    key = jax.random.key(seed)
    ks = iter(jax.random.split(key, 40))
    nrm = lambda shape, scale: scale * jax.random.normal(next(ks), shape, F32)
    n_idx = jnp.arange(S5_STATE, dtype=F32)
    dt_ssd = jnp.exp(jax.random.uniform(next(ks), (N_SSD, SSD_HEADS), F32, math.log(1e-3), math.log(1e-1)))
    return {
        'x_prompt': nrm((BATCH, SEQ, D_MODEL), 1.0),
        'x_sample': nrm((DEC_BATCH, DEC_SEQ, D_MODEL), 1.0),
        'state_s5_re': nrm((N_S5, DEC_BATCH, S5_GROUPS, S5_STATE), 0.1),
        'state_s5_im': nrm((N_S5, DEC_BATCH, S5_GROUPS, S5_STATE), 0.1),
        'state_ssd_conv': nrm((N_SSD, DEC_BATCH, SSD_CONV - 1, SSD_CONV_DIM), 1.0),
        'state_ssd_ssm': nrm((N_SSD, DEC_BATCH, SSD_HEADS, SSD_HEAD_DIM, SSD_STATE), 0.1),
        'norm_mix': 1.0 + nrm((DEPTH, D_MODEL), 0.02),
        'norm_mlp': 1.0 + nrm((DEPTH, D_MODEL), 0.02),
        'norm_final': 1.0 + nrm((D_MODEL,), 0.02),
        's5_lam_re': -0.5 + nrm((N_S5, S5_GROUPS, S5_STATE), 0.01),
        's5_lam_im': math.pi * n_idx + nrm((N_S5, S5_GROUPS, S5_STATE), 0.01),
        's5_log_dt': jax.random.uniform(next(ks), (N_S5, S5_GROUPS), F32, math.log(1e-3), math.log(1e-1)),
        's5_b_re': nrm((N_S5, S5_GROUPS, S5_STATE, S5_GROUP), (2 * S5_GROUP) ** -0.5),
        's5_b_im': nrm((N_S5, S5_GROUPS, S5_STATE, S5_GROUP), (2 * S5_GROUP) ** -0.5),
        's5_c_re': nrm((N_S5, S5_GROUPS, S5_GROUP, S5_STATE), S5_STATE ** -0.5),
        's5_c_im': nrm((N_S5, S5_GROUPS, S5_GROUP, S5_STATE), S5_STATE ** -0.5),
        's5_d': 1.0 + nrm((N_S5, D_MODEL), 0.1),
        's5_w_glu': nrm((N_S5, D_MODEL, 2 * D_MODEL), D_MODEL ** -0.5),
        'ssd_w_in': nrm((N_SSD, D_MODEL, SSD_PROJ), D_MODEL ** -0.5),
        'ssd_conv_w': nrm((N_SSD, SSD_CONV, SSD_CONV_DIM), SSD_CONV ** -0.5),
        'ssd_conv_b': nrm((N_SSD, SSD_CONV_DIM), 0.02),
        'ssd_dt_bias': dt_ssd + jnp.log(-jnp.expm1(-dt_ssd)),
        'ssd_a_log': jnp.log(jax.random.uniform(next(ks), (N_SSD, SSD_HEADS), F32, 1.0, 16.0)),
        'ssd_d': 1.0 + nrm((N_SSD, SSD_HEADS), 0.1),
        'ssd_norm': 1.0 + nrm((N_SSD, SSD_INNER), 0.02),
        'ssd_w_out': nrm((N_SSD, SSD_INNER, D_MODEL), SSD_INNER ** -0.5),
        'mlp_w1': nrm((DEPTH, D_MODEL, D_FF), D_MODEL ** -0.5),
        'mlp_w2': nrm((DEPTH, D_FF, D_MODEL), D_FF ** -0.5),
    }


def reference(x_prompt, x_sample, state_s5_re, state_s5_im, state_ssd_conv, state_ssd_ssm,
              norm_mix, norm_mlp, norm_final,
              s5_lam_re, s5_lam_im, s5_log_dt, s5_b_re, s5_b_im, s5_c_re, s5_c_im, s5_d, s5_w_glu,
              ssd_w_in, ssd_conv_w, ssd_conv_b, ssd_dt_bias, ssd_a_log, ssd_d, ssd_norm, ssd_w_out,
              mlp_w1, mlp_w2):
    def run(x, s5_h, conv_st, ssm_st):
        s5_out, conv_out, ssm_out = [], [], []
        for i in range(DEPTH):
            j = i // N_MIXERS
            u = rmsnorm(x, norm_mix[i])
            if i % N_MIXERS == 0:
                m, h = s5_mixer(u, s5_h[j], s5_lam_re[j], s5_lam_im[j], s5_log_dt[j], s5_b_re[j], s5_b_im[j],
                                s5_c_re[j], s5_c_im[j], s5_d[j], s5_w_glu[j])
                s5_out.append(h)
            else:
                m, c, s = ssd_mixer(u, conv_st[j], ssm_st[j], ssd_w_in[j], ssd_conv_w[j], ssd_conv_b[j],
                                    ssd_dt_bias[j], ssd_a_log[j], ssd_d[j], ssd_norm[j], ssd_w_out[j])
                conv_out.append(c)
                ssm_out.append(s)
            x = x + m.astype(x.dtype)
            x = x + channel_mlp(rmsnorm(x, norm_mlp[i]), mlp_w1[i], mlp_w2[i]).astype(x.dtype)
        s5_all = jnp.stack(s5_out)
        return rmsnorm(x, norm_final), jnp.real(s5_all), jnp.imag(s5_all), jnp.stack(conv_out), jnp.stack(ssm_out)

    bp = x_prompt.shape[0]
    s5_zero = jnp.zeros((N_S5, bp, S5_GROUPS, S5_STATE), jnp.complex64)
    conv_zero = jnp.zeros((N_SSD, bp, SSD_CONV - 1, SSD_CONV_DIM), F32)
    ssm_zero = jnp.zeros((N_SSD, bp, SSD_HEADS, SSD_HEAD_DIM, SSD_STATE), F32)
    y_prompt, s5_re_p, s5_im_p, conv_p, ssm_p = run(x_prompt, s5_zero, conv_zero, ssm_zero)

    s5_cache = lax.complex(state_s5_re.astype(F32), state_s5_im.astype(F32))
    y_sample, s5_re_s, s5_im_s, conv_s, ssm_s = run(x_sample, s5_cache, state_ssd_conv, state_ssd_ssm)
    return (y_prompt, y_sample, s5_re_p, s5_im_p, conv_p, ssm_p, s5_re_s, s5_im_s, conv_s, ssm_s)
```

```cpp
#include <hip/hip_runtime.h>
#include <cstdio>
#include <cstdint>
#define XB_TMO      128
#define XB_XCNT(j)  (256  + 64 * (j))
#define XB_XSUB(j)  (1280 + 64 * (j))
#define XB_XGEN(j)  (2304 + 64 * (j))
#define XB_TOP      3328
#define XB_TOPGEN   3392
#define XCD_BAR_WORDS 3456
#define XB_SPIN_CAP (1u << 18)
#define LAS __attribute__((address_space(3)))

__device__ __forceinline__ unsigned xb_ld(unsigned* p)              { return __hip_atomic_load(p, __ATOMIC_RELAXED, __HIP_MEMORY_SCOPE_AGENT); }
__device__ __forceinline__ unsigned xb_add(unsigned* p, unsigned v) { return __hip_atomic_fetch_add(p, v, __ATOMIC_RELAXED, __HIP_MEMORY_SCOPE_AGENT); }
__device__ __forceinline__ unsigned xb_xcc_id() { return (unsigned)__builtin_amdgcn_s_getreg((3 << 11) | 20) & 0xFu; }
#define XB_SPIN(cond, bar) do { unsigned _sp = 0; while (cond) { __builtin_amdgcn_s_sleep(1); \
    if ((++_sp & 255u) == 0u) { if (xb_ld(&(bar)[XB_TMO])) break; if (_sp > XB_SPIN_CAP) { atomicAdd(&(bar)[XB_TMO], 1u); break; } } } } while (0)

struct XcdBarrier {
    unsigned* bar; unsigned x;
    volatile LAS unsigned* st;
};

__device__ __forceinline__ XcdBarrier xcd_barrier_post(unsigned* bar, volatile LAS unsigned* st) {
    XcdBarrier b; b.bar = bar; b.x = xb_xcc_id(); b.st = st;
    if (threadIdx.x == 0) (void)xb_add(&bar[XB_XCNT(b.x)], 1u);
    return b;
}
__device__ __forceinline__ void xcd_barrier_complete(unsigned* bar, unsigned x, unsigned& nloc, unsigned& nx) {
    const unsigned G = gridDim.x * gridDim.y * gridDim.z;
    unsigned sum, cnt, mine, sp = 0u;
    for (;;) {
        sum = 0u; cnt = 0u; mine = 0u;
#pragma unroll
        for (unsigned j = 0; j < 16; ++j) { const unsigned c = xb_ld(&bar[XB_XCNT(j)]); sum += c; cnt += (c > 0u) ? 1u : 0u; mine = (j == x) ? c : mine; }
        if (sum == G) break;
        __builtin_amdgcn_s_sleep(1);
        if ((++sp & 255u) == 0u) { if (xb_ld(&bar[XB_TMO])) break; if (sp > XB_SPIN_CAP) { atomicAdd(&bar[XB_TMO], 1u); break; } }
    }
    nloc = mine > 0u ? mine : 1u; nx = cnt > 0u ? cnt : 1u;
}

__device__ __forceinline__ void xcd_barrier(const XcdBarrier& b) {
    asm volatile("s_waitcnt vmcnt(0)" ::: "memory");
    __syncthreads();
    if (threadIdx.x == 0) {
        unsigned* bar = b.bar;
        __builtin_amdgcn_s_waitcnt(0);
        unsigned nloc = b.st[0], nx = b.st[1];
        if (nloc == 0u) { xcd_barrier_complete(bar, b.x, nloc, nx); b.st[0] = nloc; b.st[1] = nx; }
        const unsigned old = xb_add(&bar[XB_XSUB(b.x)], 1u);
        const unsigned gen = old / nloc;
        if (old + 1u == (gen + 1u) * nloc) {
            __builtin_amdgcn_fence(__ATOMIC_RELEASE, "agent");
            asm volatile("s_waitcnt vmcnt(0)" ::: "memory");
            const unsigned og = xb_add(&bar[XB_TOP], 1u);
            const unsigned tg = og / nx;
            if (og + 1u == (tg + 1u) * nx) xb_add(&bar[XB_TOPGEN], 1u);
            else XB_SPIN(xb_ld(&bar[XB_TOPGEN]) == tg, bar);
            __builtin_amdgcn_fence(__ATOMIC_ACQUIRE, "agent");
            xb_add(&bar[XB_XGEN(b.x)], 1u);
            asm volatile("s_waitcnt vmcnt(0)" ::: "memory");
        } else {
            XB_SPIN(xb_ld(&bar[XB_XGEN(b.x)]) == gen, bar);
            __builtin_amdgcn_fence(__ATOMIC_ACQUIRE, "agent");
            asm volatile("s_waitcnt vmcnt(0)" ::: "memory");
        }
    }
    __syncthreads();
}
namespace pg8 {
#define PG8_LAS __attribute__((address_space(3)))
typedef unsigned short bf16_t;
typedef short bf16x8 __attribute__((ext_vector_type(8)));
typedef float f32x4 __attribute__((ext_vector_type(4)));
typedef unsigned u32x4 __attribute__((ext_vector_type(4)));
constexpr int BM = 256, BK = 64, HALF = 128, HTB = HALF * BK * 2  , STAGE_BYTES = 8 * HTB, NXCD = 8, WGM = 8;

__host__ __device__ __forceinline__ int lds_byte(int r, int c) { const int st = (r >> 4) * 2 + (c >> 5), rr = r & 15, cc = c & 31, ob = rr * 64 + cc * 2; return st * 1024 + (ob ^ (((ob >> 9) & 1) << 5)); }
__host__ __device__ __forceinline__ void stage_rc(int b, int& R, int& C) { const int st = b / 1024, sb = b % 1024, swz = sb ^ (((sb >> 9) & 1) << 5); R = (st >> 1) * 16 + swz / 64; C = (st & 1) * 32 + (swz % 64) / 2; }
__host__ __device__ __forceinline__ int perm32(int rho) { const int n = rho >> 4, i = rho & 15; return 8 * (i >> 2) + 4 * n + (i & 3); }

struct Unit { int pm, pn; };
struct Gemm { const bf16_t* A; const bf16_t* Bt; int M, N, K; };
struct StaticOrder {
    int nM, nN, nwg, G, c;
    __host__ __device__ void init(int M, int N, int G_, int c_) { nM = M / BM; nN = N / BM; nwg = nM * nN; G = G_; c = c_; }
    __host__ __device__ bool next(int i, Unit& u) const {
        const long L = (long)i * G + c; if (L >= nwg) return false;
        int wgid = (int)L; { const int q = nwg / NXCD, r = nwg % NXCD, xcd = wgid % NXCD, off = wgid / NXCD; wgid = (xcd < r ? xcd * (q + 1) : r * (q + 1) + (xcd - r) * q) + off; }
        const int nig = WGM * nN, gid = wgid / nig, fm = gid * WGM, gsz = (nM - fm) < WGM ? (nM - fm) : WGM;
        u.pm = fm + ((wgid % nig) % gsz); u.pn = (wgid % nig) / gsz; return true;
    }
    __device__ __forceinline__ void a_ready(const Unit&) const {}
    __device__ __forceinline__ void done(const Unit&) const {}
};
typedef float f32x2c __attribute__((ext_vector_type(2))); typedef __bf16 bf16x2c __attribute__((ext_vector_type(2)));
__device__ __forceinline__ unsigned cvt_pk_bf16(float lo, float hi) { const f32x2c v = {lo, hi}; return __builtin_bit_cast(unsigned, __builtin_convertvector(v, bf16x2c)); }
template <class Epi, class Sched, bool STAMP = false>
__device__ __forceinline__ void gemm_phase(PG8_LAS unsigned char* lds, const Gemm g, const Sched& S, const Epi& E, unsigned long long* stamps) {
    const int tid = threadIdx.x, wid = __builtin_amdgcn_readfirstlane(tid >> 6), lane = tid & 63, wr = wid >> 2, wc = wid & 3, fr = lane & 15, fq = lane >> 4;
    const int K = g.K, nt = K / BK;
    int ts_lo = 0, ts_hi = 0, nts = 0; const unsigned long long rt_entry = STAMP ? (unsigned long long)wall_clock64() : 0ull;
#define PG8_STAMP() do { if (STAMP && wid == 0 && nts < 64) { const unsigned long long _c = (unsigned long long)clock64(); \
        ts_lo = (lane == nts) ? (int)(unsigned)_c : ts_lo; ts_hi = (lane == nts) ? (int)(unsigned)(_c >> 32) : ts_hi; ++nts; } } while (0)
    PG8_STAMP();
    unsigned voffA[2], voffB[2];
#pragma unroll
    for (int i = 0; i < 2; ++i) { int R, C; stage_rc(tid * 16 + i * 8192, R, C); const int Rb = Epi::PERM ? ((R & ~31) + perm32(R & 31)) : R;
        voffA[i] = (unsigned)(R * K + C) * 2u; voffB[i] = (unsigned)(Rb * K + C) * 2u; }
    const size_t kstep = (size_t)(BK * 2);
    const size_t hstep = (size_t)HALF * K * 2;
    const size_t tstep = 2 * hstep;
    const unsigned ldsw = (unsigned)wid * 1024u;
    const int aoff = lds_byte(wr * 64 + fr, fq * 8), boff = lds_byte(wc * 32 + fr, fq * 8);
#define PG8_SA(b, h) (((b) * 2 + (h)) * HTB)
#define PG8_SB(b, h) ((4 + (b) * 2 + (h)) * HTB)
#define PG8_STAGE(bufoff, gbase, voff) do { _Pragma("unroll") for (int _i = 0; _i < 2; ++_i) \
        __builtin_amdgcn_global_load_lds((const unsigned*)((const char*)(gbase) + (voff)[_i]), (PG8_LAS unsigned*)(lds + (bufoff) + ldsw + _i * 8192), 16, 0, 0); } while (0)
#define PG8_LDA(dst, b, h) do { _Pragma("unroll") for (int m = 0; m < 4; ++m) _Pragma("unroll") for (int k = 0; k < 2; ++k) dst[m][k] = *(const PG8_LAS bf16x8*)(lds + PG8_SA(b, h) + aoff + m * 2048 + k * 1024); } while (0)
#define PG8_LDB(dst, b, h) do { _Pragma("unroll") for (int n = 0; n < 2; ++n) _Pragma("unroll") for (int k = 0; k < 2; ++k) dst[n][k] = *(const PG8_LAS bf16x8*)(lds + PG8_SB(b, h) + boff + n * 2048 + k * 1024); } while (0)
#define PG8_MMA(ai, bj, At, Bt) do { __builtin_amdgcn_s_setprio(1); _Pragma("unroll") for (int m = 0; m < 4; ++m) _Pragma("unroll") for (int n = 0; n < 2; ++n) _Pragma("unroll") for (int k = 0; k < 2; ++k) \
        acc[ai][bj][m][n] = __builtin_amdgcn_mfma_f32_16x16x32_bf16(Bt[n][k], At[m][k], acc[ai][bj][m][n], 0, 0, 0); __builtin_amdgcn_s_setprio(0); } while (0)
#define PG8_WAIT_V(n) asm volatile("s_waitcnt vmcnt(" #n ")" ::: "memory")
#define PG8_WAIT_L(n) asm volatile("s_waitcnt lgkmcnt(" #n ")" ::: "memory")
#define PG8_BAR __builtin_amdgcn_s_barrier()
#define PG8_SCHED __builtin_amdgcn_sched_barrier(0)
    Unit cur, nxt; int ui = 0;
    if (!S.next(0, cur)) return;
    f32x4 acc[2][2][4][2];
#pragma unroll
    for (int a = 0; a < 2; ++a)
#pragma unroll
        for (int b = 0; b < 2; ++b)
#pragma unroll
            for (int m = 0; m < 4; ++m)
#pragma unroll
                for (int n = 0; n < 2; ++n) acc[a][b][m][n] = (f32x4){0.f, 0.f, 0.f, 0.f};
    bf16x8 At[4][2], B0[2][2], B1[2][2];
    const char* cA = (const char*)g.A + (size_t)cur.pm * tstep; const char* cB = (const char*)g.Bt + (size_t)cur.pn * tstep;
    S.a_ready(cur);
    PG8_STAGE(PG8_SB(0, 0), cB, voffB); PG8_STAGE(PG8_SA(0, 0), cA, voffA); PG8_STAGE(PG8_SB(0, 1), cB + hstep, voffB); PG8_STAGE(PG8_SA(0, 1), cA + hstep, voffA);
    if (wr == 1) PG8_BAR;
    PG8_WAIT_V(4); PG8_BAR;
    PG8_STAGE(PG8_SB(1, 0), cB + kstep, voffB); PG8_STAGE(PG8_SA(1, 0), cA + kstep, voffA); PG8_STAGE(PG8_SB(1, 1), cB + hstep + kstep, voffB);
    PG8_WAIT_V(6); PG8_BAR;
    PG8_STAMP();
    for (;;) {
        const bool has_next = S.next(ui + 1, nxt);
        const char* nA = has_next ? (const char*)g.A + (size_t)nxt.pm * tstep : cA; const char* nB = has_next ? (const char*)g.Bt + (size_t)nxt.pn * tstep : cB;
        for (int t = 0; t < nt; t += 2) {
            const bool last = (t == nt - 2);
            const char* a1 = cA + (size_t)(t + 1) * kstep;
            const char* a2 = last ? nA : cA + (size_t)(t + 2) * kstep; const char* b2 = last ? nB : cB + (size_t)(t + 2) * kstep;
            const char* a3 = a2 + kstep; const char* b3 = b2 + kstep;
            if (last && has_next) S.a_ready(nxt);
            PG8_LDB(B0, 0, 0); PG8_SCHED; PG8_LDA(At, 0, 0); PG8_STAGE(PG8_SA(1, 1), a1 + hstep, voffA);
            PG8_WAIT_L(8); PG8_BAR; PG8_WAIT_L(0); PG8_MMA(0, 0, At, B0); PG8_BAR; PG8_SCHED;
            PG8_LDB(B1, 0, 1); PG8_STAGE(PG8_SB(0, 0), b2, voffB);
            PG8_BAR; PG8_WAIT_L(0); PG8_MMA(0, 1, At, B1); PG8_BAR;
            PG8_LDA(At, 0, 1); PG8_STAGE(PG8_SA(0, 0), a2, voffA);
            PG8_BAR; PG8_WAIT_L(0); PG8_MMA(1, 0, At, B0); PG8_BAR; PG8_SCHED;
            PG8_STAGE(PG8_SB(0, 1), b2 + hstep, voffB);
            PG8_WAIT_V(6); PG8_BAR; PG8_MMA(1, 1, At, B1); PG8_BAR;
            PG8_LDB(B0, 1, 0); PG8_SCHED; PG8_LDA(At, 1, 0); PG8_STAGE(PG8_SA(0, 1), a2 + hstep, voffA);
            PG8_WAIT_L(8); PG8_BAR; PG8_WAIT_L(0); PG8_MMA(0, 0, At, B0); PG8_BAR; PG8_SCHED;
            PG8_LDB(B1, 1, 1); PG8_STAGE(PG8_SB(1, 0), b3, voffB);
            PG8_BAR; PG8_WAIT_L(0); PG8_MMA(0, 1, At, B1); PG8_BAR;
            PG8_LDA(At, 1, 1); PG8_STAGE(PG8_SA(1, 0), a3, voffA);
            PG8_BAR; PG8_WAIT_L(0); PG8_MMA(1, 0, At, B0); PG8_BAR; PG8_SCHED;
            PG8_STAGE(PG8_SB(1, 1), b3 + hstep, voffB);
            PG8_WAIT_V(6); PG8_BAR; PG8_MMA(1, 1, At, B1); PG8_BAR;
        }
        PG8_STAMP();
        if constexpr (!Epi::AFTER_DRAIN) { E(acc, cur, wr, wc, fr, fq); S.done(cur); }
        PG8_STAMP();
        if (!has_next) break;
#pragma unroll
        for (int a = 0; a < 2; ++a)
#pragma unroll
            for (int b = 0; b < 2; ++b)
#pragma unroll
                for (int m = 0; m < 4; ++m)
#pragma unroll
                    for (int n = 0; n < 2; ++n) acc[a][b][m][n] = (f32x4){0.f, 0.f, 0.f, 0.f};
        cur = nxt; cA = nA; cB = nB; ++ui;
    }
    PG8_WAIT_V(0);
    if (wr == 0) PG8_BAR;
    PG8_BAR;
    if constexpr (Epi::AFTER_DRAIN) { E.fused(acc, cur, wr, wc, fr, fq, lds, wid, lane); S.done(cur); }
    PG8_STAMP();
    if (STAMP && wid == 0) { stamps[lane] = lane < nts ? (((unsigned long long)(unsigned)ts_hi << 32) | (unsigned)ts_lo) : 0ull;
        if (lane == 62) stamps[62] = rt_entry; if (lane == 63) stamps[63] = (unsigned long long)wall_clock64(); }
#undef PG8_STAMP
#undef PG8_SA
#undef PG8_SB
#undef PG8_STAGE
#undef PG8_LDA
#undef PG8_LDB
#undef PG8_MMA
#undef PG8_WAIT_V
#undef PG8_WAIT_L
#undef PG8_BAR
#undef PG8_SCHED
}
}
using pg8::bf16_t; using pg8::bf16x8; using pg8::f32x4; using pg8::u32x4; using pg8::cvt_pk_bf16; using pg8::Unit;
typedef unsigned u32x2 __attribute__((ext_vector_type(2)));
typedef LAS unsigned char* lptr;
constexpr int D = 2048, MP = 32768, MS = 512, M = MP + MS, DFF = 8192, DIN = 4096, CONVD = 6144, NPROJ = 10304, NPROJ_PAD = 10496, ZXW = 10240;
constexpr float EPS = 1e-5f;
constexpr size_t WS_CTL = 0, WS_R1 = 16384, R1_BYTES = (size_t)M * 4096 * 2, WS_R2 = WS_R1 + R1_BYTES, R2_BYTES = (size_t)M * ZXW * 2, WS_DT = WS_R2 + R2_BYTES, DT_BYTES = (size_t)M * 64 * 4,
                 WS_WA = WS_DT + DT_BYTES, WA_BYTES = (size_t)NPROJ_PAD * D * 2, WS_WB = WS_WA + WA_BYTES, WB_BYTES = (size_t)D * DIN * 2, WS_W1 = WS_WB + WB_BYTES, W1_BYTES = (size_t)DFF * D * 2,
                 WS_W2 = WS_W1 + W1_BYTES, WS_END = WS_W2 + W1_BYTES;
constexpr size_t O_YP = 0, O_YS = 67108864, O_S5RP = 68157440, O_S5IP = 68288512, O_CONVP = 68419584, O_SSMP = 68714496, O_S5RS = 77103104, O_S5IS = 77627392, O_CONVS = 78151680, O_SSMS = 79331328;
constexpr int LDS_BAR = 131072, LDS_BYTES = 147456;
struct Params { const float* in[28]; float* out; unsigned char* ws; int ph_lo, ph_hi; };

__device__ __forceinline__ float bflo(unsigned w) { return __uint_as_float(w << 16); }
__device__ __forceinline__ float bfhi(unsigned w) { return __uint_as_float(w & 0xffff0000u); }
__device__ __forceinline__ float wave_sum(float v) { for (int o = 32; o > 0; o >>= 1) v += __shfl_xor(v, o); return v; }
__device__ __forceinline__ float sigmoidf_(float x) { return __builtin_amdgcn_rcpf(1.0f + __expf(-x)); }
#define LDS_FENCE() asm volatile("s_waitcnt lgkmcnt(0)" ::: "memory")

__device__ __forceinline__ void convert_wt(const float* src, int K, int Nsrc, bf16_t* dst, int Npad, int mode, lptr lds) {
    LAS float* L = (LAS float*)lds; const int tid = threadIdx.x, nkt = K / 64, nT = (Npad / 64) * nkt;
    for (int t = blockIdx.x; t < nT; t += gridDim.x) {
        const int kt = t % nkt, n0 = (t / nkt) * 64, k0 = kt * 64; int col0 = n0;
        if (mode == 1) { const int pn = n0 >> 8, r = n0 & 255; col0 = (r >> 7) * 2048 + pn * 128 + (r & 127); }
        if (mode == 2 && n0 >= Nsrc) col0 = -1;
        const int kr = tid >> 4, c4 = (tid & 15) * 4;
        f32x4 v0 = {0.f, 0.f, 0.f, 0.f}, v1 = v0;
        if (col0 >= 0) { v0 = *(const f32x4*)(src + (size_t)(k0 + kr) * Nsrc + col0 + c4); v1 = *(const f32x4*)(src + (size_t)(k0 + kr + 32) * Nsrc + col0 + c4); }
        __syncthreads();
#pragma unroll
        for (int i = 0; i < 4; ++i) { L[kr * 65 + c4 + i] = v0[i]; L[(kr + 32) * 65 + c4 + i] = v1[i]; }
        __syncthreads();
        const int n = tid >> 3, k8 = (tid & 7) * 8; float f[8];
#pragma unroll
        for (int i = 0; i < 8; ++i) f[i] = L[(k8 + i) * 65 + n];
        u32x4 w; w.x = cvt_pk_bf16(f[0], f[1]); w.y = cvt_pk_bf16(f[2], f[3]); w.z = cvt_pk_bf16(f[4], f[5]); w.w = cvt_pk_bf16(f[6], f[7]);
        *(u32x4*)(dst + (size_t)(n0 + n) * K + k0 + k8) = w;
    }
    __syncthreads();
}

template <int MODE> __device__ __forceinline__ void rms_phase(const float* xp, const float* xs, float* X, const float* gain, bf16_t* A) {
    const int lane = threadIdx.x & 63, gw = blockIdx.x * 8 + (threadIdx.x >> 6), nW = gridDim.x * 8;
    f32x4 g[8];
#pragma unroll
    for (int i = 0; i < 8; ++i) g[i] = *(const f32x4*)(gain + i * 256 + lane * 4);
    for (int row = gw; row < M; row += nW) {
        const float* src = (MODE == 1) ? (row < MP ? xp + (size_t)row * D : xs + (size_t)(row - MP) * D) : X + (size_t)row * D;
        f32x4 v[8]; float ss = 0.f;
#pragma unroll
        for (int i = 0; i < 8; ++i) { v[i] = *(const f32x4*)(src + i * 256 + lane * 4); ss += v[i][0] * v[i][0] + v[i][1] * v[i][1] + v[i][2] * v[i][2] + v[i][3] * v[i][3]; }
        ss = wave_sum(ss);
        const float r = __builtin_amdgcn_rsqf(ss * (1.0f / D) + EPS);
#pragma unroll
        for (int i = 0; i < 8; ++i) {
            const f32x4 y = v[i] * r * g[i];
            if (MODE == 2) *(f32x4*)(X + (size_t)row * D + i * 256 + lane * 4) = y;
            else { u32x2 w; w.x = cvt_pk_bf16(y[0], y[1]); w.y = cvt_pk_bf16(y[2], y[3]); *(u32x2*)(A + (size_t)row * D + i * 256 + lane * 4) = w;
                   if (MODE == 1) *(f32x4*)(X + (size_t)row * D + i * 256 + lane * 4) = v[i]; }
        }
    }
}

struct EpiGlu {
    static constexpr bool PERM = false, AFTER_DRAIN = false; float* X;
    __device__ __forceinline__ void operator()(const f32x4 (&acc)[2][2][4][2], const Unit& u, int wr, int wc, int fr, int fq) const {
        const int row0 = u.pm * 256 + wr * 64 + fr, col0 = u.pn * 128 + wc * 32 + 4 * fq;
#pragma unroll
        for (int ai = 0; ai < 2; ++ai)
#pragma unroll
            for (int m = 0; m < 4; ++m) { float* rowp = X + (size_t)(row0 + ai * 128 + m * 16) * D + col0;
#pragma unroll
                for (int n = 0; n < 2; ++n) { f32x4 x = *(f32x4*)(rowp + n * 16); const f32x4 a = acc[ai][0][m][n], b = acc[ai][1][m][n];
#pragma unroll
                    for (int j = 0; j < 4; ++j) x[j] += a[j] * sigmoidf_(b[j]);
                    *(f32x4*)(rowp + n * 16) = x; } }
    }
};
struct EpiAdd {
    static constexpr bool PERM = false, AFTER_DRAIN = false; float* X;
    __device__ __forceinline__ void operator()(const f32x4 (&acc)[2][2][4][2], const Unit& u, int wr, int wc, int fr, int fq) const {
        const int row0 = u.pm * 256 + wr * 64 + fr, col0 = u.pn * 256 + wc * 32 + 4 * fq;
#pragma unroll
        for (int ai = 0; ai < 2; ++ai)
#pragma unroll
            for (int m = 0; m < 4; ++m) { float* rowp = X + (size_t)(row0 + ai * 128 + m * 16) * D + col0;
#pragma unroll
                for (int bj = 0; bj < 2; ++bj)
#pragma unroll
                    for (int n = 0; n < 2; ++n) { f32x4 x = *(f32x4*)(rowp + bj * 128 + n * 16); x += acc[ai][bj][m][n]; *(f32x4*)(rowp + bj * 128 + n * 16) = x; } }
    }
};
struct EpiRelu2 {
    static constexpr bool PERM = true, AFTER_DRAIN = false; bf16_t* O;
    __device__ __forceinline__ void operator()(const f32x4 (&acc)[2][2][4][2], const Unit& u, int wr, int wc, int fr, int fq) const {
        const int row0 = u.pm * 256 + wr * 64 + fr, col0 = u.pn * 256 + wc * 32 + 8 * fq;
#pragma unroll
        for (int ai = 0; ai < 2; ++ai)
#pragma unroll
            for (int m = 0; m < 4; ++m) { bf16_t* rowp = O + (size_t)(row0 + ai * 128 + m * 16) * DFF + col0;
#pragma unroll
                for (int bj = 0; bj < 2; ++bj) { f32x4 v0 = acc[ai][bj][m][0], v1 = acc[ai][bj][m][1];
#pragma unroll
                    for (int j = 0; j < 4; ++j) { const float a = fmaxf(v0[j], 0.f), b = fmaxf(v1[j], 0.f); v0[j] = a * a; v1[j] = b * b; }
                    u32x4 w; w.x = cvt_pk_bf16(v0[0], v0[1]); w.y = cvt_pk_bf16(v0[2], v0[3]); w.z = cvt_pk_bf16(v1[0], v1[1]); w.w = cvt_pk_bf16(v1[2], v1[3]);
                    *(u32x4*)(rowp + bj * 128) = w; } }
    }
};
struct EpiSsdIn {
    static constexpr bool PERM = true, AFTER_DRAIN = false; bf16_t* O; float* DT;
    __device__ __forceinline__ void operator()(const f32x4 (&acc)[2][2][4][2], const Unit& u, int wr, int wc, int fr, int fq) const {
        const int row0 = u.pm * 256 + wr * 64 + fr;
        if (u.pn < 40) { const int col0 = u.pn * 256 + wc * 32 + 8 * fq;
#pragma unroll
            for (int ai = 0; ai < 2; ++ai)
#pragma unroll
                for (int m = 0; m < 4; ++m) { bf16_t* rowp = O + (size_t)(row0 + ai * 128 + m * 16) * ZXW + col0;
#pragma unroll
                    for (int bj = 0; bj < 2; ++bj) { const f32x4 v0 = acc[ai][bj][m][0], v1 = acc[ai][bj][m][1];
                        u32x4 w; w.x = cvt_pk_bf16(v0[0], v0[1]); w.y = cvt_pk_bf16(v0[2], v0[3]); w.z = cvt_pk_bf16(v1[0], v1[1]); w.w = cvt_pk_bf16(v1[2], v1[3]);
                        *(u32x4*)(rowp + bj * 128) = w; } }
        } else if (wc < 2) {
#pragma unroll
            for (int ai = 0; ai < 2; ++ai)
#pragma unroll
                for (int m = 0; m < 4; ++m) { float* rowp = DT + (size_t)(row0 + ai * 128 + m * 16) * 64 + wc * 32 + 8 * fq;
                    *(f32x4*)(rowp) = acc[ai][0][m][0]; *(f32x4*)(rowp + 4) = acc[ai][0][m][1]; }
        }
    }
};
__device__ __forceinline__ void s5_phase(const Params& P, int j, const bf16_t* U, bf16_t* G, lptr lds) {
    const int tid = threadIdx.x, wid = __builtin_amdgcn_readfirstlane(tid >> 6), lane = tid & 63, fr = lane & 15, fq = lane >> 4;
    lptr Ut = lds + wid * 8704; lptr Hm = Ut + 4096;
    const int nit = wid < 4 ? 1 : 4;
    for (int it = 0; it < nit; ++it) {
        int b, g, T; size_t row0; bool smp = wid >= 4;
        if (!smp) { const int item = blockIdx.x * 4 + wid; b = item >> 7; g = item & 127; T = 4096; row0 = (size_t)b * 4096; }
        else { const int item = (blockIdx.x * 4 + (wid - 4)) + 1024 * it; b = item >> 7; g = item & 127; T = 16; row0 = (size_t)MP + b * 16; }
        const int jg = j * 128 + g;
        const float lr = P.in[9][jg * 64 + lane], li = P.in[10][jg * 64 + lane], dt = expf(P.in[11][jg]);
        const float e = expf(lr * dt), lbr = e * cosf(li * dt), lbi = e * sinf(li * dt);
        const float nr = lbr - 1.0f, ni = lbi, den = 1.0f / (lr * lr + li * li), fre = (nr * lr + ni * li) * den, fim = (ni * lr - nr * li) * den;
        float Bre[16], Bim[16];
#pragma unroll
        for (int c4 = 0; c4 < 4; ++c4) { const f32x4 br = *(const f32x4*)(P.in[12] + ((size_t)jg * 64 + lane) * 16 + c4 * 4), bi = *(const f32x4*)(P.in[13] + ((size_t)jg * 64 + lane) * 16 + c4 * 4);
#pragma unroll
            for (int i = 0; i < 4; ++i) { Bre[c4 * 4 + i] = fre * br[i] - fim * bi[i]; Bim[c4 * 4 + i] = fre * bi[i] + fim * br[i]; } }
        bf16x8 Cf[4];
#pragma unroll
        for (int kb = 0; kb < 4; ++kb) { const f32x4 cr = *(const f32x4*)(P.in[14] + ((size_t)jg * 16 + fr) * 64 + 16 * kb + 4 * fq), ci = *(const f32x4*)(P.in[15] + ((size_t)jg * 16 + fr) * 64 + 16 * kb + 4 * fq);
            u32x4 w; w.x = cvt_pk_bf16(cr[0], -ci[0]); w.y = cvt_pk_bf16(cr[1], -ci[1]); w.z = cvt_pk_bf16(cr[2], -ci[2]); w.w = cvt_pk_bf16(cr[3], -ci[3]); Cf[kb] = __builtin_bit_cast(bf16x8, w); }
        const f32x4 dsk = *(const f32x4*)(P.in[16] + (size_t)j * D + g * 16 + 4 * fq);
        float hre = 0.f, him = 0.f;
        if (smp) { hre = P.in[2][((size_t)(j * 32 + b) * 128 + g) * 64 + lane]; him = P.in[3][((size_t)(j * 32 + b) * 128 + g) * 64 + lane]; }
        for (int t0 = 0; t0 < T; t0 += 64) {
            const int ntk = (T - t0) < 64 ? (T - t0) : 64;
            if (lane < ntk) { const u32x4* up = (const u32x4*)(U + (row0 + t0 + lane) * D + g * 16); const u32x4 a = up[0], c = up[1];
                LAS f32x4* d = (LAS f32x4*)(Ut + lane * 64);
                d[0] = (f32x4){bflo(a.x), bfhi(a.x), bflo(a.y), bfhi(a.y)}; d[1] = (f32x4){bflo(a.z), bfhi(a.z), bflo(a.w), bfhi(a.w)};
                d[2] = (f32x4){bflo(c.x), bfhi(c.x), bflo(c.y), bfhi(c.y)}; d[3] = (f32x4){bflo(c.z), bfhi(c.z), bflo(c.w), bfhi(c.w)}; }
            LDS_FENCE();
            for (int tb = 0; tb < ntk; tb += 16) {
#pragma unroll 4
                for (int tt = 0; tt < 16; ++tt) {
                    const LAS f32x4* up = (const LAS f32x4*)(Ut + (tb + tt) * 64); const f32x4 u0 = up[0], u1 = up[1], u2 = up[2], u3 = up[3];
                    float bur = 0.f, bui = 0.f;
#pragma unroll
                    for (int i = 0; i < 4; ++i) { bur += Bre[i] * u0[i]; bui += Bim[i] * u0[i]; }
#pragma unroll
                    for (int i = 0; i < 4; ++i) { bur += Bre[4 + i] * u1[i]; bui += Bim[4 + i] * u1[i]; }
#pragma unroll
                    for (int i = 0; i < 4; ++i) { bur += Bre[8 + i] * u2[i]; bui += Bim[8 + i] * u2[i]; }
#pragma unroll
                    for (int i = 0; i < 4; ++i) { bur += Bre[12 + i] * u3[i]; bui += Bim[12 + i] * u3[i]; }
                    const float nre = lbr * hre - lbi * him + bur, nim = lbr * him + lbi * hre + bui; hre = nre; him = nim;
                    *(LAS unsigned*)(Hm + tt * 272 + lane * 4) = cvt_pk_bf16(hre, him);
                }
                LDS_FENCE();
                f32x4 acc = {0.f, 0.f, 0.f, 0.f};
#pragma unroll
                for (int kb = 0; kb < 4; ++kb) { const bf16x8 hb = *(const LAS bf16x8*)(Hm + fr * 272 + (32 * kb + 8 * fq) * 2); acc = __builtin_amdgcn_mfma_f32_16x16x32_bf16(Cf[kb], hb, acc, 0, 0, 0); }
                const f32x4 uu = *(const LAS f32x4*)(Ut + (tb + fr) * 64 + fq * 16);
                float y[4];
#pragma unroll
                for (int i = 0; i < 4; ++i) { const float v = acc[i] + dsk[i] * uu[i]; const float z2 = 1.5957691216f * (v + 0.044715f * v * v * v); y[i] = v * sigmoidf_(z2); }
                u32x2 w; w.x = cvt_pk_bf16(y[0], y[1]); w.y = cvt_pk_bf16(y[2], y[3]);
                *(u32x2*)(G + (row0 + t0 + tb + fr) * D + g * 16 + 4 * fq) = w;
                LDS_FENCE();
            }
        }
        const size_t so = smp ? ((size_t)(j * 32 + b) * 128 + g) * 64 + lane : ((size_t)(j * 8 + b) * 128 + g) * 64 + lane;
        P.out[(smp ? O_S5RS : O_S5RP) + so] = hre; P.out[(smp ? O_S5IS : O_S5IP) + so] = him;
    }
}

constexpr int L_BS = 0, L_CS = 17408, L_BST = 34816, L_HALF = 53248, HALF_BYTES = 36352, LH_XT = 0, LH_W = 9216, LH_HS = 18432, LH_AC = 35840, LH_DT = 36096;
__device__ __forceinline__ bf16x8 scale8(bf16x8 v, const float* t) { u32x4 w = __builtin_bit_cast(u32x4, v); u32x4 o;
    o.x = cvt_pk_bf16(bflo(w.x) * t[0], bfhi(w.x) * t[1]); o.y = cvt_pk_bf16(bflo(w.y) * t[2], bfhi(w.y) * t[3]); o.z = cvt_pk_bf16(bflo(w.z) * t[4], bfhi(w.z) * t[5]); o.w = cvt_pk_bf16(bflo(w.w) * t[6], bfhi(w.w) * t[7]);
    return __builtin_bit_cast(bf16x8, o); }
__device__ __forceinline__ void ssd_phase(const Params& P, int jj, const bf16_t* ZX, const float* DTb, bf16_t* Yg, lptr lds) {
    const int tid = threadIdx.x, wid = __builtin_amdgcn_readfirstlane(tid >> 6), lane = tid & 63, j = lane & 15, q = lane >> 4, hb = wid >> 2, wv = wid & 3;
    lptr Bs = lds + L_BS, Cs = lds + L_CS, Bst = lds + L_BST, Hf = lds + L_HALF + hb * HALF_BYTES, Xt = Hf + LH_XT, Wl = Hf + LH_W, Hs = Hf + LH_HS;
    LAS float* acs = (LAS float*)(Hf + LH_AC); LAS float* dts = (LAS float*)(Hf + LH_DT);
    for (int it = 0; it < 5; ++it) {
        const bool smp = it > 0; int b, hp, T, nsteps; size_t rowb;
        if (!smp) { b = blockIdx.x >> 5; hp = blockIdx.x & 31; T = 64; nsteps = 64; rowb = (size_t)b * 4096; }
        else { const int id = blockIdx.x * 4 + (it - 1); b = id >> 5; hp = id & 31; T = 16; nsteps = 1; rowb = (size_t)MP + b * 16; }
        const int g = hp >> 2, h = 2 * hp + hb;
        const int o = tid % 48, seg = tid / 48; const bool cact = tid < 384; int zcol, ch, kind, sub;
        if (o < 16) { kind = 0; sub = o >> 3; ch = (2 * hp + sub) * 64 + (o & 7) * 8; } else if (o < 32) { kind = 1; sub = 0; ch = 4096 + g * 128 + (o - 16) * 8; } else { kind = 2; sub = 0; ch = 5120 + g * 128 + (o - 32) * 8; }
        zcol = 4096 + ch;
        const float dtb = P.in[21][jj * 64 + h], aneg = -expf(P.in[22][jj * 64 + h]), dsk = P.in[23][jj * 64 + h];
        f32x4 st[2][4];
#pragma unroll
        for (int nt2 = 0; nt2 < 2; ++nt2)
#pragma unroll
            for (int pt = 0; pt < 4; ++pt) {
                st[nt2][pt] = smp ? *(const f32x4*)(P.in[5] + ((((size_t)jj * 32 + b) * 64 + h) * 64 + 16 * pt + j) * 128 + 16 * (2 * wv + nt2) + 4 * q) : (f32x4){0.f, 0.f, 0.f, 0.f};
                u32x2 w; w.x = cvt_pk_bf16(st[nt2][pt][0], st[nt2][pt][1]); w.y = cvt_pk_bf16(st[nt2][pt][2], st[nt2][pt][3]);
                *(LAS u32x2*)(Hs + (16 * pt + j) * 272 + (16 * (2 * wv + nt2) + 4 * q) * 2) = w; }
        for (int step = 0; step < nsteps; ++step) {
            const size_t R = rowb + (size_t)step * 64;
            if (wv == 0) { float dtv = 0.f; if (lane < T) { const float x = DTb[(R + lane) * 64 + h] + dtb; dtv = x > 20.f ? x : log1pf(__expf(x)); }
                float cs = dtv * aneg;
#pragma unroll
                for (int o2 = 1; o2 < 64; o2 <<= 1) { const float t = __shfl_up(cs, o2); if (lane >= o2) cs += t; }
                acs[lane] = cs; dts[lane] = dtv; }
            if (cact) {
#pragma unroll 1
              for (int hf = 0; hf < 2; ++hf) {
                const int ch4 = ch + hf * 4;
                float cw[4][4], cb[4];
#pragma unroll
                for (int k = 0; k < 4; ++k) { const f32x4 a = *(const f32x4*)(P.in[19] + ((size_t)jj * 4 + k) * CONVD + ch4);
#pragma unroll
                    for (int i = 0; i < 4; ++i) cw[k][i] = a[i]; }
                { const f32x4 a = *(const f32x4*)(P.in[20] + (size_t)jj * CONVD + ch4);
#pragma unroll
                    for (int i = 0; i < 4; ++i) cb[i] = a[i]; }
                u32x2 raw[11];
#pragma unroll
                for (int i = 0; i < 11; ++i) { const int l = seg * 8 + i - 3;
                    u32x2 v = {0u, 0u};
                    if (l < T) {
                        if (l >= 0 || step > 0) v = *(const u32x2*)(ZX + (R + l) * ZXW + zcol + hf * 4);
                        else if (smp) { const float* cp = P.in[4] + (((size_t)jj * 32 + b) * 3 + (l + 3)) * CONVD + ch4; const f32x4 a = *(const f32x4*)cp;
                            v.x = cvt_pk_bf16(a[0], a[1]); v.y = cvt_pk_bf16(a[2], a[3]); }
                    }
                    raw[i] = v; }
                unsigned tp[4][4];
#pragma unroll
                for (int r = 0; r < 8; r += 2) {
                    float o0[4], o1[4];
#pragma unroll
                    for (int c = 0; c < 4; ++c) { o0[c] = cb[c]; o1[c] = cb[c]; }
#pragma unroll
                    for (int k = 0; k < 4; ++k) { const u32x2 a = raw[r + k], c2 = raw[r + 1 + k];
                        const float xa[4] = {bflo(a.x), bfhi(a.x), bflo(a.y), bfhi(a.y)};
                        const float xc[4] = {bflo(c2.x), bfhi(c2.x), bflo(c2.y), bfhi(c2.y)};
#pragma unroll
                        for (int c = 0; c < 4; ++c) { o0[c] += cw[k][c] * xa[c]; o1[c] += cw[k][c] * xc[c]; } }
                    const bool v0 = (seg * 8 + r) < T, v1 = (seg * 8 + r + 1) < T;
#pragma unroll
                    for (int c = 0; c < 4; ++c) { o0[c] = v0 ? o0[c] * sigmoidf_(o0[c]) : 0.f; o1[c] = v1 ? o1[c] * sigmoidf_(o1[c]) : 0.f; tp[c][r >> 1] = cvt_pk_bf16(o0[c], o1[c]); }
                    if (kind != 0) { lptr dst = (kind == 1 ? Bs : Cs) + (seg * 8 + r) * 272 + (ch4 & 127) * 2;
                        u32x2 w0, w1; w0.x = cvt_pk_bf16(o0[0], o0[1]); w0.y = cvt_pk_bf16(o0[2], o0[3]); w1.x = cvt_pk_bf16(o1[0], o1[1]); w1.y = cvt_pk_bf16(o1[2], o1[3]);
                        *(LAS u32x2*)dst = w0; *(LAS u32x2*)(dst + 272) = w1; }
                }
                if (kind != 2) { lptr dst = (kind == 0 ? (lds + L_HALF + sub * HALF_BYTES + LH_XT) + (ch4 & 63) * 144 : Bst + (ch4 & 127) * 144) + seg * 16;
#pragma unroll
                    for (int c = 0; c < 4; ++c) { u32x4 w; w.x = tp[c][0]; w.y = tp[c][1]; w.z = tp[c][2]; w.w = tp[c][3]; *(LAS u32x4*)(dst + c * 144) = w; } }
              }
            }
            __syncthreads();
            const int l = 16 * wv + j; const float acl = acs[l], ac63 = acs[63];
            bf16x8 Cf[4];
#pragma unroll
            for (int kb = 0; kb < 4; ++kb) Cf[kb] = *(const LAS bf16x8*)(Cs + l * 272 + (32 * kb + 8 * q) * 2);
#pragma unroll
            for (int s4 = 0; s4 < 4; ++s4) { f32x4 a4 = {0.f, 0.f, 0.f, 0.f};
                if (s4 <= wv) {
#pragma unroll
                    for (int kb = 0; kb < 4; ++kb) { const bf16x8 bf = *(const LAS bf16x8*)(Bs + (16 * s4 + j) * 272 + (32 * kb + 8 * q) * 2); a4 = __builtin_amdgcn_mfma_f32_16x16x32_bf16(bf, Cf[kb], a4, 0, 0, 0); }
                    const f32x4 as = *(const LAS f32x4*)(acs + 16 * s4 + 4 * q), ds = *(const LAS f32x4*)(dts + 16 * s4 + 4 * q);
#pragma unroll
                    for (int i = 0; i < 4; ++i) { const int s = 16 * s4 + 4 * q + i; a4[i] = (s <= l) ? a4[i] * __expf(acl - as[i]) * ds[i] : 0.f; } }
                u32x2 w; w.x = cvt_pk_bf16(a4[0], a4[1]); w.y = cvt_pk_bf16(a4[2], a4[3]);
                *(LAS u32x2*)(Wl + l * 144 + (16 * s4 + 4 * q) * 2) = w; }
            LDS_FENCE();
            f32x4 Ya[4];
            { const float el = __expf(acl);
#pragma unroll
              for (int pt = 0; pt < 4; ++pt) { f32x4 yi = {0.f, 0.f, 0.f, 0.f};
#pragma unroll
                for (int kb = 0; kb < 4; ++kb) { const bf16x8 hf = *(const LAS bf16x8*)(Hs + (16 * pt + j) * 272 + (32 * kb + 8 * q) * 2); yi = __builtin_amdgcn_mfma_f32_16x16x32_bf16(hf, Cf[kb], yi, 0, 0, 0); }
                Ya[pt] = yi * el; } }
            bf16x8 Xf[2][4];
#pragma unroll
            for (int kb = 0; kb < 2; ++kb) { const bf16x8 wf = *(const LAS bf16x8*)(Wl + l * 144 + (32 * kb + 8 * q) * 2);
#pragma unroll
                for (int pt = 0; pt < 4; ++pt) { Xf[kb][pt] = *(const LAS bf16x8*)(Xt + (16 * pt + j) * 144 + (32 * kb + 8 * q) * 2); Ya[pt] = __builtin_amdgcn_mfma_f32_16x16x32_bf16(Xf[kb][pt], wf, Ya[pt], 0, 0, 0); } }
            if (l < T) {
#pragma unroll
                for (int pt = 0; pt < 4; ++pt) { const int p0 = 16 * pt + 4 * q; const u32x2 zz = *(const u32x2*)(ZX + (R + l) * ZXW + h * 64 + p0);
                    const float zf[4] = {bflo(zz.x), bfhi(zz.x), bflo(zz.y), bfhi(zz.y)}; float y[4];
#pragma unroll
                    for (int i = 0; i < 4; ++i) { const float xv = __uint_as_float((unsigned)(*(const LAS unsigned short*)(Xt + (p0 + i) * 144 + l * 2)) << 16); y[i] = (Ya[pt][i] + dsk * xv) * zf[i] * sigmoidf_(zf[i]); }
                    u32x2 w; w.x = cvt_pk_bf16(y[0], y[1]); w.y = cvt_pk_bf16(y[2], y[3]); *(u32x2*)(Yg + (R + l) * DIN + h * 64 + p0) = w; }
            }
            { const float dec = __expf(ac63);
#pragma unroll
              for (int nt2 = 0; nt2 < 2; ++nt2)
#pragma unroll
                for (int pt = 0; pt < 4; ++pt) st[nt2][pt] *= dec;
#pragma unroll
              for (int kb = 0; kb < 2; ++kb) { float tl[8]; const f32x4 a0 = *(const LAS f32x4*)(acs + 32 * kb + 8 * q), a1 = *(const LAS f32x4*)(acs + 32 * kb + 8 * q + 4), d0 = *(const LAS f32x4*)(dts + 32 * kb + 8 * q), d1 = *(const LAS f32x4*)(dts + 32 * kb + 8 * q + 4);
#pragma unroll
                for (int i = 0; i < 4; ++i) { tl[i] = __expf(ac63 - a0[i]) * d0[i]; tl[4 + i] = __expf(ac63 - a1[i]) * d1[i]; }
                bf16x8 bfr[2];
#pragma unroll
                for (int nt2 = 0; nt2 < 2; ++nt2) bfr[nt2] = *(const LAS bf16x8*)(Bst + (16 * (2 * wv + nt2) + j) * 144 + (32 * kb + 8 * q) * 2);
#pragma unroll
                for (int pt = 0; pt < 4; ++pt) { const bf16x8 xs = scale8(Xf[kb][pt], tl);
#pragma unroll
                    for (int nt2 = 0; nt2 < 2; ++nt2) st[nt2][pt] = __builtin_amdgcn_mfma_f32_16x16x32_bf16(bfr[nt2], xs, st[nt2][pt], 0, 0, 0); } } }
            __syncthreads();
#pragma unroll
            for (int nt2 = 0; nt2 < 2; ++nt2)
#pragma unroll
                for (int pt = 0; pt < 4; ++pt) { u32x2 w; w.x = cvt_pk_bf16(st[nt2][pt][0], st[nt2][pt][1]); w.y = cvt_pk_bf16(st[nt2][pt][2], st[nt2][pt][3]);
                    *(LAS u32x2*)(Hs + (16 * pt + j) * 272 + (16 * (2 * wv + nt2) + 4 * q) * 2) = w; }
        }
        float* so = P.out + (smp ? O_SSMS + (((size_t)jj * 32 + b) * 64 + h) * 8192 : O_SSMP + (((size_t)jj * 8 + b) * 64 + h) * 8192);
#pragma unroll
        for (int nt2 = 0; nt2 < 2; ++nt2)
#pragma unroll
            for (int pt = 0; pt < 4; ++pt) *(f32x4*)(so + (16 * pt + j) * 128 + 16 * (2 * wv + nt2) + 4 * q) = st[nt2][pt];
        __syncthreads();
    }
}
__device__ __forceinline__ void gnorm_phase(const Params& P, int jj, bf16_t* Yg, const bf16_t* ZX) {
    const int lane = threadIdx.x & 63, gw = blockIdx.x * 8 + (threadIdx.x >> 6), nW = gridDim.x * 8;
    for (int idx = gw; idx < M * 8; idx += nW) {
        const int row = idx >> 3, gi = idx & 7; bf16_t* p = Yg + (size_t)row * DIN + gi * 512 + lane * 8;
        const u32x4 v = *(const u32x4*)p; float f[8] = {bflo(v.x), bfhi(v.x), bflo(v.y), bfhi(v.y), bflo(v.z), bfhi(v.z), bflo(v.w), bfhi(v.w)};
        float ss = 0.f;
#pragma unroll
        for (int i = 0; i < 8; ++i) ss += f[i] * f[i];
        ss = wave_sum(ss); const float r = __builtin_amdgcn_rsqf(ss * (1.0f / 512.0f) + EPS);
        const float* nw = P.in[24] + (size_t)jj * DIN + gi * 512 + lane * 8; const f32x4 w0 = *(const f32x4*)nw, w1 = *(const f32x4*)(nw + 4);
        u32x4 o; o.x = cvt_pk_bf16(f[0] * r * w0[0], f[1] * r * w0[1]); o.y = cvt_pk_bf16(f[2] * r * w0[2], f[3] * r * w0[3]); o.z = cvt_pk_bf16(f[4] * r * w1[0], f[5] * r * w1[1]); o.w = cvt_pk_bf16(f[6] * r * w1[2], f[7] * r * w1[3]);
        *(u32x4*)p = o;
    }
    const int gt = blockIdx.x * 512 + threadIdx.x, nTh = gridDim.x * 512;
    for (int e = gt; e < 40 * 3 * CONVD; e += nTh) {
        const int ch = e % CONVD, r = (e / CONVD) % 3, bb = e / (3 * CONVD);
        const size_t row = bb < 8 ? (size_t)bb * 4096 + 4093 + r : (size_t)MP + (bb - 8) * 16 + 13 + r;
        const float v = __uint_as_float((unsigned)ZX[row * ZXW + 4096 + ch] << 16);
        if (bb < 8) P.out[O_CONVP + (((size_t)jj * 8 + bb) * 3 + r) * CONVD + ch] = v; else P.out[O_CONVS + (((size_t)jj * 32 + (bb - 8)) * 3 + r) * CONVD + ch] = v;
    }
}

__global__ void __launch_bounds__(512, 2) fwd(Params P) {
    extern __shared__ __attribute__((aligned(16))) unsigned char shm[];
    lptr lds = (lptr)shm;
    if (threadIdx.x < 4) ((LAS unsigned*)(lds + LDS_BAR))[threadIdx.x] = 0u;
    __syncthreads();
    const int lo = P.ph_lo, hi = P.ph_hi;
    unsigned char* ws = P.ws;
    XcdBarrier bar; bar.bar = (unsigned*)(ws + WS_CTL); bar.x = 0; bar.st = (volatile LAS unsigned*)(lds + LDS_BAR);
    if (hi - lo > 1) bar = xcd_barrier_post((unsigned*)(ws + WS_CTL), (volatile LAS unsigned*)(lds + LDS_BAR));
    float* X = P.out;
    bf16_t* A = (bf16_t*)(ws + WS_R1); bf16_t* G2 = A + (size_t)M * D; bf16_t* R2 = (bf16_t*)(ws + WS_R2); float* DTb = (float*)(ws + WS_DT);
    bf16_t* WA = (bf16_t*)(ws + WS_WA); bf16_t* WB = (bf16_t*)(ws + WS_WB); bf16_t* W1 = (bf16_t*)(ws + WS_W1); bf16_t* W2 = (bf16_t*)(ws + WS_W2);
    const int G = gridDim.x, c = blockIdx.x;
#define RUN(k) (lo <= (k) && (k) < hi)
#define SEAM(k) do { if ((k) + 1 < hi) xcd_barrier(bar); } while (0)
#ifdef NO_S5
#define S5_CALL
#else
#define S5_CALL s5_phase(P, jx, A, G2, lds)
#endif
#ifdef NO_SSD
#define SSD_CALL
#else
#define SSD_CALL ssd_phase(P, jx, R2, DTb, A, lds)
#endif
#define LAYER(i) { \
        const int jx = i >> 1, pb = i * 8; \
        if ((i & 1) == 0) { \
            if (RUN(pb + 0)) { \
                convert_wt(P.in[17] + (size_t)jx * D * 4096, D, 4096, WA, 4096, 1, lds); \
                convert_wt(P.in[26] + (size_t)i * D * DFF, D, DFF, W1, DFF, 0, lds); \
                convert_wt(P.in[27] + (size_t)i * DFF * D, DFF, D, W2, D, 0, lds); \
                if (i == 0) rms_phase<1>(P.in[0], P.in[1], X, P.in[6] + (size_t)i * D, A); else rms_phase<0>(nullptr, nullptr, X, P.in[6] + (size_t)i * D, A); \
                SEAM(pb + 0); } \
            if (RUN(pb + 1)) { \
 S5_CALL; \
 SEAM(pb + 1); } \
            if (RUN(pb + 2)) { pg8::Gemm g{G2, WA, M, 4096, D}; pg8::StaticOrder S; S.init(M, 4096, G, c); EpiGlu E{X}; pg8::gemm_phase<EpiGlu, pg8::StaticOrder, false>(lds, g, S, E, nullptr); SEAM(pb + 2); } \
        } else { \
            if (RUN(pb + 0)) { \
                convert_wt(P.in[18] + (size_t)jx * D * NPROJ, D, NPROJ, WA, NPROJ_PAD, 2, lds); \
                convert_wt(P.in[25] + (size_t)jx * DIN * D, DIN, D, WB, D, 0, lds); \
                convert_wt(P.in[26] + (size_t)i * D * DFF, D, DFF, W1, DFF, 0, lds); \
                convert_wt(P.in[27] + (size_t)i * DFF * D, DFF, D, W2, D, 0, lds); \
                rms_phase<0>(nullptr, nullptr, X, P.in[6] + (size_t)i * D, A); \
                SEAM(pb + 0); } \
            if (RUN(pb + 1)) { pg8::Gemm g{A, WA, M, NPROJ_PAD, D}; pg8::StaticOrder S; S.init(M, NPROJ_PAD, G, c); EpiSsdIn E{R2, DTb}; pg8::gemm_phase<EpiSsdIn, pg8::StaticOrder, false>(lds, g, S, E, nullptr); SEAM(pb + 1); } \
            if (RUN(pb + 2)) { \
 SSD_CALL; \
 SEAM(pb + 2); } \
            if (RUN(pb + 3)) { gnorm_phase(P, jx, A, R2); SEAM(pb + 3); } \
            if (RUN(pb + 4)) { pg8::Gemm g{A, WB, M, D, DIN}; pg8::StaticOrder S; S.init(M, D, G, c); EpiAdd E{X}; pg8::gemm_phase<EpiAdd, pg8::StaticOrder, false>(lds, g, S, E, nullptr); SEAM(pb + 4); } \
        } \
        if (RUN(pb + 5)) { rms_phase<0>(nullptr, nullptr, X, P.in[7] + (size_t)i * D, A); SEAM(pb + 5); } \
        if (RUN(pb + 6)) { pg8::Gemm g{A, W1, M, DFF, D}; pg8::StaticOrder S; S.init(M, DFF, G, c); EpiRelu2 E{R2}; pg8::gemm_phase<EpiRelu2, pg8::StaticOrder, false>(lds, g, S, E, nullptr); SEAM(pb + 6); } \
        if (RUN(pb + 7)) { pg8::Gemm g{R2, W2, M, D, DFF}; pg8::StaticOrder S; S.init(M, D, G, c); EpiAdd E{X}; pg8::gemm_phase<EpiAdd, pg8::StaticOrder, false>(lds, g, S, E, nullptr); SEAM(pb + 7); } \
}
    LAYER(0) LAYER(1) LAYER(2) LAYER(3)
    if (RUN(32)) rms_phase<2>(nullptr, nullptr, X, P.in[8], nullptr);
}

#ifndef BISECT
#define BISECT 0
#endif
#ifndef N_LAUNCH_PER_PHASE
#define N_LAUNCH_PER_PHASE 0
#endif
extern "C" void kernel_launch(void* const* d_in, const int* in_sizes, int n_in, void* d_out, int out_size, void* d_ws, size_t ws_size, hipStream_t stream) {
    static int grid = 0;
    if (grid == 0) {
        if (n_in != 28 || ws_size < WS_END) { fprintf(stderr, "kernel_launch: need 28 inputs and %zu bytes of workspace; got %d, %zu\n", (size_t)WS_END, n_in, ws_size); grid = -1; return; }
        int dev = 0, cus = 0, per_cu = 0;
        if (hipGetDevice(&dev) != hipSuccess || hipDeviceGetAttribute(&cus, hipDeviceAttributeMultiprocessorCount, dev) != hipSuccess) { grid = -1; return; }
        if (hipFuncSetAttribute((const void*)fwd, hipFuncAttributeMaxDynamicSharedMemorySize, LDS_BYTES) != hipSuccess) { fprintf(stderr, "kernel_launch: hipFuncSetAttribute failed\n"); grid = -1; return; }
        if (hipOccupancyMaxActiveBlocksPerMultiprocessor(&per_cu, (const void*)fwd, 512, LDS_BYTES) != hipSuccess || per_cu < 1) fprintf(stderr, "kernel_launch: occupancy query says %d\n", per_cu);
        (void)hipGetLastError();
        grid = cus < 256 ? cus : 256;
    }
    if (grid < 0) return;
    (void)hipMemsetAsync((char*)d_ws + WS_CTL, 0, 16384, stream);
    Params p{};
    for (int i = 0; i < 28; ++i) p.in[i] = (const float*)d_in[i];
    p.out = (float*)d_out; p.ws = (unsigned char*)d_ws;
#if N_LAUNCH_PER_PHASE
    for (int k = 0; k <= 32; ++k) { const int s = k & 7; if (k < 32 && (((k >> 3) & 1) == 0) && (s == 3 || s == 4)) continue;
#if BISECT == 1
        if (k < 32 && (((k >> 3) & 1) == 1) && s >= 1 && s <= 4) continue;
#elif BISECT == 3
        if (k < 32 && (((k >> 3) & 1) == 1) && s >= 2 && s <= 3) continue;
#elif BISECT == 4
        if (k < 32 && (((k >> 3) & 1) == 1) && s == 3) continue;
#elif BISECT == 2
        if (k < 32 && (((k >> 3) & 1) == 0) && s >= 1 && s <= 2) continue;
#endif
 p.ph_lo = k; p.ph_hi = k + 1; hipLaunchKernelGGL(fwd, dim3(grid), dim3(512), LDS_BYTES, stream, p); }
#else
    p.ph_lo = 0; p.ph_hi = 33;
    hipLaunchKernelGGL(fwd, dim3(grid), dim3(512), LDS_BYTES, stream, p);
#endif
    const hipError_t le = hipPeekAtLastError();
    if (le != hipSuccess) fprintf(stderr, "kernel_launch: launch failed: %s\n", hipGetErrorName(le));
}
```

```cpp
#include <hip/hip_runtime.h>
#include <cstdio>
#include <cstdint>
#define XB_TMO      128
#define XB_XCNT(j)  (256  + 64 * (j))
#define XB_XSUB(j)  (1280 + 64 * (j))
#define XB_XGEN(j)  (2304 + 64 * (j))
#define XB_TOP      3328
#define XB_TOPGEN   3392
#define XCD_BAR_WORDS 3456
#define XB_SPIN_CAP (1u << 18)
#define LAS __attribute__((address_space(3)))

__device__ __forceinline__ unsigned xb_ld(unsigned* p)              { return __hip_atomic_load(p, __ATOMIC_RELAXED, __HIP_MEMORY_SCOPE_AGENT); }
__device__ __forceinline__ unsigned xb_add(unsigned* p, unsigned v) { return __hip_atomic_fetch_add(p, v, __ATOMIC_RELAXED, __HIP_MEMORY_SCOPE_AGENT); }
__device__ __forceinline__ unsigned xb_xcc_id() { return (unsigned)__builtin_amdgcn_s_getreg((3 << 11) | 20) & 0xFu; }
#define XB_SPIN(cond, bar) do { unsigned _sp = 0; while (cond) { __builtin_amdgcn_s_sleep(1); \
    if ((++_sp & 255u) == 0u) { if (xb_ld(&(bar)[XB_TMO])) break; if (_sp > XB_SPIN_CAP) { atomicAdd(&(bar)[XB_TMO], 1u); break; } } } } while (0)

struct XcdBarrier {
    unsigned* bar; unsigned x;
    volatile LAS unsigned* st;
};

__device__ __forceinline__ XcdBarrier xcd_barrier_post(unsigned* bar, volatile LAS unsigned* st) {
    XcdBarrier b; b.bar = bar; b.x = xb_xcc_id(); b.st = st;
    if (threadIdx.x == 0) (void)xb_add(&bar[XB_XCNT(b.x)], 1u);
    return b;
}
__device__ __forceinline__ void xcd_barrier_complete(unsigned* bar, unsigned x, unsigned& nloc, unsigned& nx) {
    const unsigned G = gridDim.x * gridDim.y * gridDim.z;
    unsigned sum, cnt, mine, sp = 0u;
    for (;;) {
        sum = 0u; cnt = 0u; mine = 0u;
#pragma unroll
        for (unsigned j = 0; j < 16; ++j) { const unsigned c = xb_ld(&bar[XB_XCNT(j)]); sum += c; cnt += (c > 0u) ? 1u : 0u; mine = (j == x) ? c : mine; }
        if (sum == G) break;
        __builtin_amdgcn_s_sleep(1);
        if ((++sp & 255u) == 0u) { if (xb_ld(&bar[XB_TMO])) break; if (sp > XB_SPIN_CAP) { atomicAdd(&bar[XB_TMO], 1u); break; } }
    }
    nloc = mine > 0u ? mine : 1u; nx = cnt > 0u ? cnt : 1u;
}

__device__ __forceinline__ void xcd_barrier(const XcdBarrier& b) {
    asm volatile("s_waitcnt vmcnt(0)" ::: "memory");
    __syncthreads();
    if (threadIdx.x == 0) {
        unsigned* bar = b.bar;
        __builtin_amdgcn_s_waitcnt(0);
        unsigned nloc = b.st[0], nx = b.st[1];
        if (nloc == 0u) { xcd_barrier_complete(bar, b.x, nloc, nx); b.st[0] = nloc; b.st[1] = nx; }
        const unsigned old = xb_add(&bar[XB_XSUB(b.x)], 1u);
        const unsigned gen = old / nloc;
        if (old + 1u == (gen + 1u) * nloc) {
            __builtin_amdgcn_fence(__ATOMIC_RELEASE, "agent");
            asm volatile("s_waitcnt vmcnt(0)" ::: "memory");
            const unsigned og = xb_add(&bar[XB_TOP], 1u);
            const unsigned tg = og / nx;
            if (og + 1u == (tg + 1u) * nx) xb_add(&bar[XB_TOPGEN], 1u);
            else XB_SPIN(xb_ld(&bar[XB_TOPGEN]) == tg, bar);
            __builtin_amdgcn_fence(__ATOMIC_ACQUIRE, "agent");
            xb_add(&bar[XB_XGEN(b.x)], 1u);
            asm volatile("s_waitcnt vmcnt(0)" ::: "memory");
        } else {
            XB_SPIN(xb_ld(&bar[XB_XGEN(b.x)]) == gen, bar);
            __builtin_amdgcn_fence(__ATOMIC_ACQUIRE, "agent");
            asm volatile("s_waitcnt vmcnt(0)" ::: "memory");
        }
    }
    __syncthreads();
}
namespace pg8 {
#define PG8_LAS __attribute__((address_space(3)))
typedef unsigned short bf16_t;
typedef short bf16x8 __attribute__((ext_vector_type(8)));
typedef float f32x4 __attribute__((ext_vector_type(4)));
typedef unsigned u32x4 __attribute__((ext_vector_type(4)));
constexpr int BM = 256, BK = 64, HALF = 128, HTB = HALF * BK * 2  , STAGE_BYTES = 8 * HTB, NXCD = 8, WGM = 8;

__host__ __device__ __forceinline__ int lds_byte(int r, int c) { const int st = (r >> 4) * 2 + (c >> 5), rr = r & 15, cc = c & 31, ob = rr * 64 + cc * 2; return st * 1024 + (ob ^ (((ob >> 9) & 1) << 5)); }
__host__ __device__ __forceinline__ void stage_rc(int b, int& R, int& C) { const int st = b / 1024, sb = b % 1024, swz = sb ^ (((sb >> 9) & 1) << 5); R = (st >> 1) * 16 + swz / 64; C = (st & 1) * 32 + (swz % 64) / 2; }
__host__ __device__ __forceinline__ int perm32(int rho) { const int n = rho >> 4, i = rho & 15; return 8 * (i >> 2) + 4 * n + (i & 3); }

struct Unit { int pm, pn, koff; };
struct Gemm { const bf16_t* A; const bf16_t* Bt; int M, N, K, ld; };
struct StaticOrder {
    int nM, nN, nwg, G, c;
    __host__ __device__ void init(int M, int N, int G_, int c_) { nM = M / BM; nN = N / BM; nwg = nM * nN; G = G_; c = c_; }
    __host__ __device__ bool next(int i, Unit& u) const {
        const long L = (long)i * G + c; if (L >= nwg) return false;
        int wgid = (int)L; { const int q = nwg / NXCD, r = nwg % NXCD, xcd = wgid % NXCD, off = wgid / NXCD; wgid = (xcd < r ? xcd * (q + 1) : r * (q + 1) + (xcd - r) * q) + off; }
        const int nig = WGM * nN, gid = wgid / nig, fm = gid * WGM, gsz = (nM - fm) < WGM ? (nM - fm) : WGM;
        u.pm = fm + ((wgid % nig) % gsz); u.pn = (wgid % nig) / gsz; u.koff = 0; return true;
    }
    __device__ __forceinline__ void a_ready(const Unit&) const {}
    __device__ __forceinline__ void done(const Unit&) const {}
};
typedef float f32x2c __attribute__((ext_vector_type(2))); typedef __bf16 bf16x2c __attribute__((ext_vector_type(2)));
__device__ __forceinline__ unsigned cvt_pk_bf16(float lo, float hi) { const f32x2c v = {lo, hi}; return __builtin_bit_cast(unsigned, __builtin_convertvector(v, bf16x2c)); }
template <class Epi, class Sched, bool STAMP = false>
__device__ __forceinline__ void gemm_phase(PG8_LAS unsigned char* lds, const Gemm g, const Sched& S, const Epi& E, unsigned long long* stamps) {
    const int tid = threadIdx.x, wid = __builtin_amdgcn_readfirstlane(tid >> 6), lane = tid & 63, wr = wid >> 2, wc = wid & 3, fr = lane & 15, fq = lane >> 4;
    const int K = g.K, nt = K / BK, LD = g.ld ? g.ld : g.K;
    int ts_lo = 0, ts_hi = 0, nts = 0; const unsigned long long rt_entry = STAMP ? (unsigned long long)wall_clock64() : 0ull;
#define PG8_STAMP() do { if (STAMP && wid == 0 && nts < 64) { const unsigned long long _c = (unsigned long long)clock64(); \
        ts_lo = (lane == nts) ? (int)(unsigned)_c : ts_lo; ts_hi = (lane == nts) ? (int)(unsigned)(_c >> 32) : ts_hi; ++nts; } } while (0)
    PG8_STAMP();
    unsigned voffA[2], voffB[2];
#pragma unroll
    for (int i = 0; i < 2; ++i) { int R, C; stage_rc(tid * 16 + i * 8192, R, C); const int Rb = Epi::PERM ? ((R & ~31) + perm32(R & 31)) : R;
        voffA[i] = (unsigned)(R * LD + C) * 2u; voffB[i] = (unsigned)(Rb * LD + C) * 2u; }
    const size_t kstep = (size_t)(BK * 2);
    const size_t hstep = (size_t)HALF * LD * 2;
    const size_t tstep = 2 * hstep;
    const unsigned ldsw = (unsigned)wid * 1024u;
    const int aoff = lds_byte(wr * 64 + fr, fq * 8), boff = lds_byte(wc * 32 + fr, fq * 8);
#define PG8_SA(b, h) (((b) * 2 + (h)) * HTB)
#define PG8_SB(b, h) ((4 + (b) * 2 + (h)) * HTB)
#define PG8_STAGE(bufoff, gbase, voff) do { _Pragma("unroll") for (int _i = 0; _i < 2; ++_i) \
        __builtin_amdgcn_global_load_lds((const unsigned*)((const char*)(gbase) + (voff)[_i]), (PG8_LAS unsigned*)(lds + (bufoff) + ldsw + _i * 8192), 16, 0, 0); } while (0)
#define PG8_LDA(dst, b, h) do { _Pragma("unroll") for (int m = 0; m < 4; ++m) _Pragma("unroll") for (int k = 0; k < 2; ++k) dst[m][k] = *(const PG8_LAS bf16x8*)(lds + PG8_SA(b, h) + aoff + m * 2048 + k * 1024); } while (0)
#define PG8_LDB(dst, b, h) do { _Pragma("unroll") for (int n = 0; n < 2; ++n) _Pragma("unroll") for (int k = 0; k < 2; ++k) dst[n][k] = *(const PG8_LAS bf16x8*)(lds + PG8_SB(b, h) + boff + n * 2048 + k * 1024); } while (0)
#define PG8_MMA(ai, bj, At, Bt) do { __builtin_amdgcn_s_setprio(1); _Pragma("unroll") for (int m = 0; m < 4; ++m) _Pragma("unroll") for (int n = 0; n < 2; ++n) _Pragma("unroll") for (int k = 0; k < 2; ++k) \
        acc[ai][bj][m][n] = __builtin_amdgcn_mfma_f32_16x16x32_bf16(Bt[n][k], At[m][k], acc[ai][bj][m][n], 0, 0, 0); __builtin_amdgcn_s_setprio(0); } while (0)
#define PG8_WAIT_V(n) asm volatile("s_waitcnt vmcnt(" #n ")" ::: "memory")
#define PG8_WAIT_L(n) asm volatile("s_waitcnt lgkmcnt(" #n ")" ::: "memory")
#define PG8_BAR __builtin_amdgcn_s_barrier()
#define PG8_SCHED __builtin_amdgcn_sched_barrier(0)
    Unit cur, nxt; int ui = 0;
    if (!S.next(0, cur)) return;
    f32x4 acc[2][2][4][2];
#pragma unroll
    for (int a = 0; a < 2; ++a)
#pragma unroll
        for (int b = 0; b < 2; ++b)
#pragma unroll
            for (int m = 0; m < 4; ++m)
#pragma unroll
                for (int n = 0; n < 2; ++n) acc[a][b][m][n] = (f32x4){0.f, 0.f, 0.f, 0.f};
    bf16x8 At[4][2], B0[2][2], B1[2][2];
    const char* cA = (const char*)g.A + (size_t)cur.pm * tstep + (size_t)cur.koff * 2; const char* cB = (const char*)g.Bt + (size_t)cur.pn * tstep + (size_t)cur.koff * 2;
    S.a_ready(cur);
    PG8_STAGE(PG8_SB(0, 0), cB, voffB); PG8_STAGE(PG8_SA(0, 0), cA, voffA); PG8_STAGE(PG8_SB(0, 1), cB + hstep, voffB); PG8_STAGE(PG8_SA(0, 1), cA + hstep, voffA);
    if (wr == 1) PG8_BAR;
    PG8_WAIT_V(4); PG8_BAR;
    PG8_STAGE(PG8_SB(1, 0), cB + kstep, voffB); PG8_STAGE(PG8_SA(1, 0), cA + kstep, voffA); PG8_STAGE(PG8_SB(1, 1), cB + hstep + kstep, voffB);
    PG8_WAIT_V(6); PG8_BAR;
    PG8_STAMP();
    for (;;) {
        const bool has_next = S.next(ui + 1, nxt);
        const char* nA = has_next ? (const char*)g.A + (size_t)nxt.pm * tstep + (size_t)nxt.koff * 2 : cA; const char* nB = has_next ? (const char*)g.Bt + (size_t)nxt.pn * tstep + (size_t)nxt.koff * 2 : cB;
        for (int t = 0; t < nt; t += 2) {
            const bool last = (t == nt - 2);
            const char* a1 = cA + (size_t)(t + 1) * kstep;
            const char* a2 = last ? nA : cA + (size_t)(t + 2) * kstep; const char* b2 = last ? nB : cB + (size_t)(t + 2) * kstep;
            const char* a3 = a2 + kstep; const char* b3 = b2 + kstep;
            if (last && has_next) S.a_ready(nxt);
            PG8_LDB(B0, 0, 0); PG8_SCHED; PG8_LDA(At, 0, 0); PG8_STAGE(PG8_SA(1, 1), a1 + hstep, voffA);
            PG8_WAIT_L(8); PG8_BAR; PG8_WAIT_L(0); PG8_MMA(0, 0, At, B0); PG8_BAR; PG8_SCHED;
            PG8_LDB(B1, 0, 1); PG8_STAGE(PG8_SB(0, 0), b2, voffB);
            PG8_BAR; PG8_WAIT_L(0); PG8_MMA(0, 1, At, B1); PG8_BAR;
            PG8_LDA(At, 0, 1); PG8_STAGE(PG8_SA(0, 0), a2, voffA);
            PG8_BAR; PG8_WAIT_L(0); PG8_MMA(1, 0, At, B0); PG8_BAR; PG8_SCHED;
            PG8_STAGE(PG8_SB(0, 1), b2 + hstep, voffB);
            PG8_WAIT_V(6); PG8_BAR; PG8_MMA(1, 1, At, B1); PG8_BAR;
            PG8_LDB(B0, 1, 0); PG8_SCHED; PG8_LDA(At, 1, 0); PG8_STAGE(PG8_SA(0, 1), a2 + hstep, voffA);
            PG8_WAIT_L(8); PG8_BAR; PG8_WAIT_L(0); PG8_MMA(0, 0, At, B0); PG8_BAR; PG8_SCHED;
            PG8_LDB(B1, 1, 1); PG8_STAGE(PG8_SB(1, 0), b3, voffB);
            PG8_BAR; PG8_WAIT_L(0); PG8_MMA(0, 1, At, B1); PG8_BAR;
            PG8_LDA(At, 1, 1); PG8_STAGE(PG8_SA(1, 0), a3, voffA);
            PG8_BAR; PG8_WAIT_L(0); PG8_MMA(1, 0, At, B0); PG8_BAR; PG8_SCHED;
            PG8_STAGE(PG8_SB(1, 1), b3 + hstep, voffB);
            PG8_WAIT_V(6); PG8_BAR; PG8_MMA(1, 1, At, B1); PG8_BAR;
        }
        PG8_STAMP();
        if constexpr (!Epi::AFTER_DRAIN) { E(acc, cur, wr, wc, fr, fq); S.done(cur); }
        PG8_STAMP();
        if (!has_next) break;
#pragma unroll
        for (int a = 0; a < 2; ++a)
#pragma unroll
            for (int b = 0; b < 2; ++b)
#pragma unroll
                for (int m = 0; m < 4; ++m)
#pragma unroll
                    for (int n = 0; n < 2; ++n) acc[a][b][m][n] = (f32x4){0.f, 0.f, 0.f, 0.f};
        cur = nxt; cA = nA; cB = nB; ++ui;
    }
    PG8_WAIT_V(0);
    if (wr == 0) PG8_BAR;
    PG8_BAR;
    if constexpr (Epi::AFTER_DRAIN) { E.fused(acc, cur, wr, wc, fr, fq, lds, wid, lane); S.done(cur); }
    PG8_STAMP();
    if (STAMP && wid == 0) { stamps[lane] = lane < nts ? (((unsigned long long)(unsigned)ts_hi << 32) | (unsigned)ts_lo) : 0ull;
        if (lane == 62) stamps[62] = rt_entry; if (lane == 63) stamps[63] = (unsigned long long)wall_clock64(); }
#undef PG8_STAMP
#undef PG8_SA
#undef PG8_SB
#undef PG8_STAGE
#undef PG8_LDA
#undef PG8_LDB
#undef PG8_MMA
#undef PG8_WAIT_V
#undef PG8_WAIT_L
#undef PG8_BAR
#undef PG8_SCHED
}
}
using pg8::bf16_t; using pg8::bf16x8; using pg8::f32x4; using pg8::u32x4; using pg8::cvt_pk_bf16; using pg8::Unit;
typedef unsigned u32x2 __attribute__((ext_vector_type(2)));
typedef float f32x2v __attribute__((ext_vector_type(2)));
typedef LAS unsigned char* lptr;
constexpr int D = 2048, MP = 32768, MS = 512, M = MP + MS, DFF = 8192, DIN = 4096, CONVD = 6144, NPROJ = 10304, NPROJ_PAD = 10496, ZXW = 10240;
constexpr float EPS = 1e-5f;
constexpr size_t WS_CTL = 0, WS_R1 = 16384, R1_BYTES = (size_t)M * 4096 * 2, WS_R2 = WS_R1 + R1_BYTES, R2_BYTES = (size_t)M * ZXW * 2, WS_DT = WS_R2 + R2_BYTES, DT_BYTES = (size_t)M * 64 * 4,
                 WS_WA = WS_DT + DT_BYTES, WA_BYTES = (size_t)NPROJ_PAD * D * 2, WS_WB = WS_WA + WA_BYTES, WB_BYTES = (size_t)D * DIN * 2, WS_W1 = WS_WB + WB_BYTES, W1_BYTES = (size_t)DFF * D * 2,
                 WS_W2 = WS_W1 + W1_BYTES, WS_PART = WS_W2 + W1_BYTES, WS_END = WS_PART + (size_t)16 * MS * D * 4;
constexpr size_t O_YP = 0, O_YS = 67108864, O_S5RP = 68157440, O_S5IP = 68288512, O_CONVP = 68419584, O_SSMP = 68714496, O_S5RS = 77103104, O_S5IS = 77627392, O_CONVS = 78151680, O_SSMS = 79331328;
constexpr int LDS_BAR = 131072, LDS_BYTES = 147456;
struct Params { const float* in[28]; float* out; unsigned char* ws; int ph_lo, ph_hi; };

__device__ __forceinline__ float bflo(unsigned w) { return __uint_as_float(w << 16); }
__device__ __forceinline__ float bfhi(unsigned w) { return __uint_as_float(w & 0xffff0000u); }
__device__ __forceinline__ float wave_sum(float v) { for (int o = 32; o > 0; o >>= 1) v += __shfl_xor(v, o); return v; }
__device__ __forceinline__ float sigmoidf_(float x) { return __builtin_amdgcn_rcpf(1.0f + __expf(-x)); }
#define LDS_FENCE() asm volatile("s_waitcnt lgkmcnt(0)" ::: "memory")

__device__ __forceinline__ void convert_wt(const float* src, int K, int Nsrc, bf16_t* dst, int Npad, int mode, lptr lds) {
    const int tid = threadIdx.x, nkt = K / 64, nT = (Npad / 64) * nkt, kr = tid >> 4, c4 = (tid & 15) * 4, G = gridDim.x;
    f32x4 v0 = {0.f, 0.f, 0.f, 0.f}, v1 = v0;
#define CW_LOAD(tt) do { const int kt_ = (tt) % nkt, n0_ = ((tt) / nkt) * 64, k0_ = kt_ * 64; int col0_ = n0_; \
        if (mode == 1) { const int pn_ = n0_ >> 8, r_ = n0_ & 255; col0_ = (r_ >> 7) * 2048 + pn_ * 128 + (r_ & 127); } \
        if (mode == 2 && n0_ >= Nsrc) col0_ = -1; \
        if (col0_ >= 0) { v0 = *(const f32x4*)(src + (size_t)(k0_ + kr) * Nsrc + col0_ + c4); v1 = *(const f32x4*)(src + (size_t)(k0_ + kr + 32) * Nsrc + col0_ + c4); } \
        else { v0 = (f32x4){0.f, 0.f, 0.f, 0.f}; v1 = v0; } } while (0)
    int t = blockIdx.x, buf = 0;
    if (t < nT) CW_LOAD(t);
    for (; t < nT; t += G) {
        const f32x4 c0 = v0, c1 = v1; const int kt = t % nkt, n0 = (t / nkt) * 64, k0 = kt * 64;
        if (t + G < nT) CW_LOAD(t + G);
        LAS float* L = (LAS float*)(lds + buf * 16640);
#pragma unroll
        for (int i = 0; i < 4; ++i) { L[kr * 65 + c4 + i] = c0[i]; L[(kr + 32) * 65 + c4 + i] = c1[i]; }
        __syncthreads();
        const int n = tid >> 3, k8 = (tid & 7) * 8; float f[8];
#pragma unroll
        for (int i = 0; i < 8; ++i) f[i] = L[(k8 + i) * 65 + n];
        u32x4 w; w.x = cvt_pk_bf16(f[0], f[1]); w.y = cvt_pk_bf16(f[2], f[3]); w.z = cvt_pk_bf16(f[4], f[5]); w.w = cvt_pk_bf16(f[6], f[7]);
        *(u32x4*)(dst + (size_t)(n0 + n) * K + k0 + k8) = w;
        buf ^= 1;
    }
#undef CW_LOAD
    __syncthreads();
}

template <int MODE> __device__ __forceinline__ void rms_phase(const float* xp, const float* xs, float* X, const float* gain, bf16_t* A, const float* Pp = nullptr) {
    const int lane = threadIdx.x & 63, gw = blockIdx.x * 8 + (threadIdx.x >> 6), nW = gridDim.x * 8;
    f32x4 g[8];
#pragma unroll
    for (int i = 0; i < 8; ++i) g[i] = *(const f32x4*)(gain + i * 256 + lane * 4);
    for (int row = gw; row < M; row += nW) {
        const float* src = (MODE == 1) ? (row < MP ? xp + (size_t)row * D : xs + (size_t)(row - MP) * D) : X + (size_t)row * D;
        f32x4 v[8]; float ss = 0.f;
#pragma unroll
        for (int i = 0; i < 8; ++i) v[i] = *(const f32x4*)(src + i * 256 + lane * 4);
        if (MODE != 1 && Pp != nullptr && row >= MP) {
#pragma unroll 1
            for (int ks = 0; ks < 16; ++ks) { const float* pp = Pp + ((size_t)ks * MS + (row - MP)) * D + lane * 4;
#pragma unroll
                for (int i = 0; i < 8; ++i) v[i] += *(const f32x4*)(pp + i * 256); }
            if (MODE == 0) {
#pragma unroll
                for (int i = 0; i < 8; ++i) *(f32x4*)(X + (size_t)row * D + i * 256 + lane * 4) = v[i]; }
        }
#pragma unroll
        for (int i = 0; i < 8; ++i) ss += v[i][0] * v[i][0] + v[i][1] * v[i][1] + v[i][2] * v[i][2] + v[i][3] * v[i][3];
        ss = wave_sum(ss);
        const float r = __builtin_amdgcn_rsqf(ss * (1.0f / D) + EPS);
#pragma unroll
        for (int i = 0; i < 8; ++i) {
            const f32x4 y = v[i] * r * g[i];
            if (MODE == 2) *(f32x4*)(X + (size_t)row * D + i * 256 + lane * 4) = y;
            else { u32x2 w; w.x = cvt_pk_bf16(y[0], y[1]); w.y = cvt_pk_bf16(y[2], y[3]); *(u32x2*)(A + (size_t)row * D + i * 256 + lane * 4) = w;
                 }
        }
    }
}

struct EpiGlu {
    static constexpr bool PERM = false, AFTER_DRAIN = false; float* X; const float* rp; const float* rs;
    __device__ __forceinline__ void operator()(const f32x4 (&acc)[2][2][4][2], const Unit& u, int wr, int wc, int fr, int fq) const {
        const int row0 = u.pm * 256 + wr * 64 + fr, col0 = u.pn * 128 + wc * 32 + 4 * fq;
        const float* rsrc = u.pm < 128 ? rp : rs - (size_t)MP * D;
#pragma unroll
        for (int ai = 0; ai < 2; ++ai)
#pragma unroll
            for (int m = 0; m < 4; ++m) { float* rowp = X + (size_t)(row0 + ai * 128 + m * 16) * D + col0; const float* srcp = rsrc + (size_t)(row0 + ai * 128 + m * 16) * D + col0;
#pragma unroll
                for (int n = 0; n < 2; ++n) { f32x4 x = *(const f32x4*)(srcp + n * 16); const f32x4 a = acc[ai][0][m][n], b = acc[ai][1][m][n];
#pragma unroll
                    for (int j = 0; j < 4; ++j) x[j] += a[j] * sigmoidf_(b[j]);
                    *(f32x4*)(rowp + n * 16) = x; } }
    }
};
struct EpiAdd {
    static constexpr bool PERM = false, AFTER_DRAIN = false; float* X;
    __device__ __forceinline__ void operator()(const f32x4 (&acc)[2][2][4][2], const Unit& u, int wr, int wc, int fr, int fq) const {
        const int row0 = u.pm * 256 + wr * 64 + fr, col0 = u.pn * 256 + wc * 32 + 4 * fq;
#pragma unroll
        for (int ai = 0; ai < 2; ++ai)
#pragma unroll
            for (int m = 0; m < 4; ++m) { float* rowp = X + (size_t)(row0 + ai * 128 + m * 16) * D + col0;
#pragma unroll
                for (int bj = 0; bj < 2; ++bj)
#pragma unroll
                    for (int n = 0; n < 2; ++n) { f32x4 x = *(f32x4*)(rowp + bj * 128 + n * 16); x += acc[ai][bj][m][n]; *(f32x4*)(rowp + bj * 128 + n * 16) = x; } }
    }
};
struct TailOrder {
    int nN, S, kslice, G, c;
    __device__ bool next(int i, Unit& u) const { const int L = i * G + c; if (L >= 2 * nN * S) return false; u.pm = 128 + (L & 1); const int r = L >> 1; u.pn = r % nN; u.koff = (r / nN) * kslice; return true; }
    __device__ __forceinline__ void a_ready(const Unit&) const {}
    __device__ __forceinline__ void done(const Unit&) const {}
};
struct EpiPartial {
    static constexpr bool PERM = false, AFTER_DRAIN = false; float* Pp; int kslice;
    __device__ __forceinline__ void operator()(const f32x4 (&acc)[2][2][4][2], const Unit& u, int wr, int wc, int fr, int fq) const {
        const int row0 = (u.pm - 128) * 256 + wr * 64 + fr, col0 = u.pn * 256 + wc * 32 + 4 * fq, ks = u.koff / kslice;
#pragma unroll
        for (int ai = 0; ai < 2; ++ai)
#pragma unroll
            for (int m = 0; m < 4; ++m) { float* rowp = Pp + ((size_t)ks * MS + row0 + ai * 128 + m * 16) * D + col0;
#pragma unroll
                for (int bj = 0; bj < 2; ++bj)
#pragma unroll
                    for (int n = 0; n < 2; ++n) *(f32x4*)(rowp + bj * 128 + n * 16) = acc[ai][bj][m][n]; }
    }
};
struct EpiRelu2 {
    static constexpr bool PERM = true, AFTER_DRAIN = false; bf16_t* O;
    __device__ __forceinline__ void operator()(const f32x4 (&acc)[2][2][4][2], const Unit& u, int wr, int wc, int fr, int fq) const {
        const int row0 = u.pm * 256 + wr * 64 + fr, col0 = u.pn * 256 + wc * 32 + 8 * fq;
#pragma unroll
        for (int ai = 0; ai < 2; ++ai)
#pragma unroll
            for (int m = 0; m < 4; ++m) { bf16_t* rowp = O + (size_t)(row0 + ai * 128 + m * 16) * DFF + col0;
#pragma unroll
                for (int bj = 0; bj < 2; ++bj) { f32x4 v0 = acc[ai][bj][m][0], v1 = acc[ai][bj][m][1];
#pragma unroll
                    for (int j = 0; j < 4; ++j) { const float a = fmaxf(v0[j], 0.f), b = fmaxf(v1[j], 0.f); v0[j] = a * a; v1[j] = b * b; }
                    u32x4 w; w.x = cvt_pk_bf16(v0[0], v0[1]); w.y = cvt_pk_bf16(v0[2], v0[3]); w.z = cvt_pk_bf16(v1[0], v1[1]); w.w = cvt_pk_bf16(v1[2], v1[3]);
                    *(u32x4*)(rowp + bj * 128) = w; } }
    }
};
struct EpiSsdIn {
    static constexpr bool PERM = true, AFTER_DRAIN = false; bf16_t* O; float* DT;
    __device__ __forceinline__ void operator()(const f32x4 (&acc)[2][2][4][2], const Unit& u, int wr, int wc, int fr, int fq) const {
        const int row0 = u.pm * 256 + wr * 64 + fr;
        if (u.pn < 40) { const int col0 = u.pn * 256 + wc * 32 + 8 * fq;
#pragma unroll
            for (int ai = 0; ai < 2; ++ai)
#pragma unroll
                for (int m = 0; m < 4; ++m) { bf16_t* rowp = O + (size_t)(row0 + ai * 128 + m * 16) * ZXW + col0;
#pragma unroll
                    for (int bj = 0; bj < 2; ++bj) { const f32x4 v0 = acc[ai][bj][m][0], v1 = acc[ai][bj][m][1];
                        u32x4 w; w.x = cvt_pk_bf16(v0[0], v0[1]); w.y = cvt_pk_bf16(v0[2], v0[3]); w.z = cvt_pk_bf16(v1[0], v1[1]); w.w = cvt_pk_bf16(v1[2], v1[3]);
                        *(u32x4*)(rowp + bj * 128) = w; } }
        } else if (wc < 2) {
#pragma unroll
            for (int ai = 0; ai < 2; ++ai)
#pragma unroll
                for (int m = 0; m < 4; ++m) { float* rowp = DT + (size_t)(row0 + ai * 128 + m * 16) * 64 + wc * 32 + 8 * fq;
                    *(f32x4*)(rowp) = acc[ai][0][m][0]; *(f32x4*)(rowp + 4) = acc[ai][0][m][1]; }
        }
    }
};
__device__ __forceinline__ void s5_phase(const Params& P, int j, const bf16_t* U, bf16_t* G, lptr lds) {
    const int tid = threadIdx.x, wid = __builtin_amdgcn_readfirstlane(tid >> 6), lane = tid & 63, fr = lane & 15, fq = lane >> 4;
    lptr Ut = lds + wid * 8704; lptr Hm = Ut + 4096;
    const int nit = wid < 4 ? 1 : 4;
    for (int it = 0; it < nit; ++it) {
        int b, g, T; size_t row0; bool smp = wid >= 4;
        if (!smp) { const int item = blockIdx.x * 4 + wid; b = item >> 7; g = item & 127; T = 4096; row0 = (size_t)b * 4096; }
        else { const int item = (blockIdx.x * 4 + (wid - 4)) + 1024 * it; b = item >> 7; g = item & 127; T = 16; row0 = (size_t)MP + b * 16; }
        const int jg = j * 128 + g;
        const float lr = P.in[9][jg * 64 + lane], li = P.in[10][jg * 64 + lane], dt = expf(P.in[11][jg]);
        const float e = expf(lr * dt), lbr = e * cosf(li * dt), lbi = e * sinf(li * dt);
        const float nr = lbr - 1.0f, ni = lbi, den = 1.0f / (lr * lr + li * li), fre = (nr * lr + ni * li) * den, fim = (ni * lr - nr * li) * den;
        float Bre[16], Bim[16];
#pragma unroll
        for (int c4 = 0; c4 < 4; ++c4) { const f32x4 br = *(const f32x4*)(P.in[12] + ((size_t)jg * 64 + lane) * 16 + c4 * 4), bi = *(const f32x4*)(P.in[13] + ((size_t)jg * 64 + lane) * 16 + c4 * 4);
#pragma unroll
            for (int i = 0; i < 4; ++i) { Bre[c4 * 4 + i] = fre * br[i] - fim * bi[i]; Bim[c4 * 4 + i] = fre * bi[i] + fim * br[i]; } }
        f32x2v B2[16];
#pragma unroll
        for (int i = 0; i < 16; ++i) B2[i] = (f32x2v){Bre[i], Bim[i]};
        bf16x8 Cf[4];
#pragma unroll
        for (int kb = 0; kb < 4; ++kb) { const f32x4 cr = *(const f32x4*)(P.in[14] + ((size_t)jg * 16 + fr) * 64 + 16 * kb + 4 * fq), ci = *(const f32x4*)(P.in[15] + ((size_t)jg * 16 + fr) * 64 + 16 * kb + 4 * fq);
            u32x4 w; w.x = cvt_pk_bf16(cr[0], -ci[0]); w.y = cvt_pk_bf16(cr[1], -ci[1]); w.z = cvt_pk_bf16(cr[2], -ci[2]); w.w = cvt_pk_bf16(cr[3], -ci[3]); Cf[kb] = __builtin_bit_cast(bf16x8, w); }
        const f32x4 dsk = *(const f32x4*)(P.in[16] + (size_t)j * D + g * 16 + 4 * fq);
        float hre = 0.f, him = 0.f;
        if (smp) { hre = P.in[2][((size_t)(j * 32 + b) * 128 + g) * 64 + lane]; him = P.in[3][((size_t)(j * 32 + b) * 128 + g) * 64 + lane]; }
        for (int t0 = 0; t0 < T; t0 += 64) {
            const int ntk = (T - t0) < 64 ? (T - t0) : 64;
            if (lane < ntk) { const u32x4* up = (const u32x4*)(U + (row0 + t0 + lane) * D + g * 16); const u32x4 a = up[0], c = up[1];
                LAS f32x4* d = (LAS f32x4*)(Ut + lane * 64);
                d[0] = (f32x4){bflo(a.x), bfhi(a.x), bflo(a.y), bfhi(a.y)}; d[1] = (f32x4){bflo(a.z), bfhi(a.z), bflo(a.w), bfhi(a.w)};
                d[2] = (f32x4){bflo(c.x), bfhi(c.x), bflo(c.y), bfhi(c.y)}; d[3] = (f32x4){bflo(c.z), bfhi(c.z), bflo(c.w), bfhi(c.w)}; }
            LDS_FENCE();
            for (int tb = 0; tb < ntk; tb += 16) {
#pragma unroll 8
                for (int tt = 0; tt < 16; ++tt) {
                    const LAS f32x4* up = (const LAS f32x4*)(Ut + (tb + tt) * 64); const f32x4 u0 = up[0], u1 = up[1], u2 = up[2], u3 = up[3];
                    f32x2v bu0 = {0.f, 0.f}, bu1 = {0.f, 0.f};
#pragma unroll
                    for (int i = 0; i < 4; i += 2) { bu0 += B2[i] * u0[i]; bu1 += B2[i + 1] * u0[i + 1]; bu0 += B2[4 + i] * u1[i]; bu1 += B2[5 + i] * u1[i + 1]; bu0 += B2[8 + i] * u2[i]; bu1 += B2[9 + i] * u2[i + 1]; bu0 += B2[12 + i] * u3[i]; bu1 += B2[13 + i] * u3[i + 1]; }
                    const f32x2v hs = {-him, hre}, hh = {hre, him};
                    const f32x2v nh = hh * lbr + (hs * lbi + (bu0 + bu1)); hre = nh.x; him = nh.y;
                    *(LAS unsigned*)(Hm + tt * 272 + lane * 4) = cvt_pk_bf16(hre, him);
                }
                LDS_FENCE();
                f32x4 acc = {0.f, 0.f, 0.f, 0.f};
#pragma unroll
                for (int kb = 0; kb < 4; ++kb) { const bf16x8 hb = *(const LAS bf16x8*)(Hm + fr * 272 + (32 * kb + 8 * fq) * 2); acc = __builtin_amdgcn_mfma_f32_16x16x32_bf16(Cf[kb], hb, acc, 0, 0, 0); }
                const f32x4 uu = *(const LAS f32x4*)(Ut + (tb + fr) * 64 + fq * 16);
                float y[4];
#pragma unroll
                for (int i = 0; i < 4; ++i) { const float v = acc[i] + dsk[i] * uu[i]; const float z2 = 1.5957691216f * (v + 0.044715f * v * v * v); y[i] = v * sigmoidf_(z2); }
                u32x2 w; w.x = cvt_pk_bf16(y[0], y[1]); w.y = cvt_pk_bf16(y[2], y[3]);
                *(u32x2*)(G + (row0 + t0 + tb + fr) * D + g * 16 + 4 * fq) = w;
                LDS_FENCE();
            }
        }
        const size_t so = smp ? ((size_t)(j * 32 + b) * 128 + g) * 64 + lane : ((size_t)(j * 8 + b) * 128 + g) * 64 + lane;
        P.out[(smp ? O_S5RS : O_S5RP) + so] = hre; P.out[(smp ? O_S5IS : O_S5IP) + so] = him;
    }
}

constexpr int L_BS = 0, L_CS = 17408, L_BST = 34816, L_HALF = 53248, HALF_BYTES = 36352, LH_XT = 0, LH_W = 9216, LH_HS = 18432, LH_AC = 35840, LH_DT = 36096;
__device__ __forceinline__ bf16x8 scale8(bf16x8 v, const float* t) { u32x4 w = __builtin_bit_cast(u32x4, v); u32x4 o;
    o.x = cvt_pk_bf16(bflo(w.x) * t[0], bfhi(w.x) * t[1]); o.y = cvt_pk_bf16(bflo(w.y) * t[2], bfhi(w.y) * t[3]); o.z = cvt_pk_bf16(bflo(w.z) * t[4], bfhi(w.z) * t[5]); o.w = cvt_pk_bf16(bflo(w.w) * t[6], bfhi(w.w) * t[7]);
    return __builtin_bit_cast(bf16x8, o); }
__device__ __forceinline__ void ssd_phase(const Params& P, int jj, const bf16_t* ZX, const float* DTb, bf16_t* Yg, lptr lds) {
    const int tid = threadIdx.x, wid = __builtin_amdgcn_readfirstlane(tid >> 6), lane = tid & 63, j = lane & 15, q = lane >> 4, hb = wid >> 2, wv = wid & 3;
    lptr Bs = lds + L_BS, Cs = lds + L_CS, Bst = lds + L_BST, Hf = lds + L_HALF + hb * HALF_BYTES, Xt = Hf + LH_XT, Wl = Hf + LH_W, Hs = Hf + LH_HS;
    LAS float* acs = (LAS float*)(Hf + LH_AC); LAS float* dts = (LAS float*)(Hf + LH_DT);
    for (int it = 0; it < 5; ++it) {
        const bool smp = it > 0; int b, hp, T, nsteps; size_t rowb;
        if (!smp) { b = blockIdx.x >> 5; hp = blockIdx.x & 31; T = 64; nsteps = 64; rowb = (size_t)b * 4096; }
        else { const int id = blockIdx.x * 4 + (it - 1); b = id >> 5; hp = id & 31; T = 16; nsteps = 1; rowb = (size_t)MP + b * 16; }
        const int g = hp >> 2, h = 2 * hp + hb;
        const int o = tid % 48, seg = tid / 48; const bool cact = tid < 384; int zcol, ch, kind, sub;
        if (o < 16) { kind = 0; sub = o >> 3; ch = (2 * hp + sub) * 64 + (o & 7) * 8; } else if (o < 32) { kind = 1; sub = 0; ch = 4096 + g * 128 + (o - 16) * 8; } else { kind = 2; sub = 0; ch = 5120 + g * 128 + (o - 32) * 8; }
        zcol = 4096 + ch;
        const float dtb = P.in[21][jj * 64 + h], aneg = -expf(P.in[22][jj * 64 + h]), dsk = P.in[23][jj * 64 + h];
        LAS float* cwl = (LAS float*)(lds + 132096);
        if (tid < 48) {
#pragma unroll
            for (int hf = 0; hf < 2; ++hf) { LAS f32x4* d = (LAS f32x4*)(cwl + (o * 2 + hf) * 20);
#pragma unroll
                for (int k = 0; k < 4; ++k) d[k] = *(const f32x4*)(P.in[19] + ((size_t)jj * 4 + k) * CONVD + ch + hf * 4);
                d[4] = *(const f32x4*)(P.in[20] + (size_t)jj * CONVD + ch + hf * 4); } }
#define SSD_LOAD_RAW(stepv) do { const size_t Rn_ = rowb + (size_t)(stepv) * 64; \
    _Pragma("unroll") for (int hf = 0; hf < 2; ++hf) _Pragma("unroll") for (int i = 0; i < 11; ++i) { const int l_ = seg * 8 + i - 3; u32x2 v_ = {0u, 0u}; \
        if (l_ < T) { if (l_ >= 0 || (stepv) > 0) v_ = *(const u32x2*)(ZX + (Rn_ + l_) * ZXW + zcol + hf * 4); \
            else if (smp) { const f32x4 a_ = *(const f32x4*)(P.in[4] + (((size_t)jj * 32 + b) * 3 + (l_ + 3)) * CONVD + ch + hf * 4); v_.x = cvt_pk_bf16(a_[0], a_[1]); v_.y = cvt_pk_bf16(a_[2], a_[3]); } } \
        raw[hf][i] = v_; } } while (0)
        float dtn = 0.f; if (wv == 0 && lane < T) dtn = DTb[(rowb + lane) * 64 + h];
        __syncthreads();
        f32x4 st[2][4];
#pragma unroll
        for (int nt2 = 0; nt2 < 2; ++nt2)
#pragma unroll
            for (int pt = 0; pt < 4; ++pt) {
                st[nt2][pt] = smp ? *(const f32x4*)(P.in[5] + ((((size_t)jj * 32 + b) * 64 + h) * 64 + 16 * pt + j) * 128 + 16 * (2 * wv + nt2) + 4 * q) : (f32x4){0.f, 0.f, 0.f, 0.f};
                u32x2 w; w.x = cvt_pk_bf16(st[nt2][pt][0], st[nt2][pt][1]); w.y = cvt_pk_bf16(st[nt2][pt][2], st[nt2][pt][3]);
                *(LAS u32x2*)(Hs + (16 * pt + j) * 272 + (16 * (2 * wv + nt2) + 4 * q) * 2) = w; }
        for (int step = 0; step < nsteps; ++step) {
            const size_t R = rowb + (size_t)step * 64;
            if (wv == 0) { float dtv = 0.f; if (lane < T) { const float x = dtn + dtb; dtv = x > 20.f ? x : log1pf(__expf(x)); }
                float cs = dtv * aneg;
#pragma unroll
                for (int o2 = 1; o2 < 64; o2 <<= 1) { const float t = __shfl_up(cs, o2); if (lane >= o2) cs += t; }
                acs[lane] = cs; dts[lane] = dtv; }
            if (cact) {
#pragma unroll 1
              for (int hf = 0; hf < 2; ++hf) {
                const int ch4 = ch + hf * 4;
                u32x2 raw[11];
#pragma unroll
                for (int i = 0; i < 11; ++i) { const int l_ = seg * 8 + i - 3; u32x2 v_ = {0u, 0u};
                    if (l_ < T) { if (l_ >= 0 || step > 0) v_ = *(const u32x2*)(ZX + (R + l_) * ZXW + zcol + hf * 4);
                        else if (smp) { const f32x4 a_ = *(const f32x4*)(P.in[4] + (((size_t)jj * 32 + b) * 3 + (l_ + 3)) * CONVD + ch4); v_.x = cvt_pk_bf16(a_[0], a_[1]); v_.y = cvt_pk_bf16(a_[2], a_[3]); } }
                    raw[i] = v_; }
                float cw[4][4], cb[4];
                { const LAS f32x4* wp = (const LAS f32x4*)(cwl + (o * 2 + hf) * 20);
#pragma unroll
                  for (int k = 0; k < 4; ++k) { const f32x4 a = wp[k];
#pragma unroll
                    for (int i = 0; i < 4; ++i) cw[k][i] = a[i]; }
                  const f32x4 a = wp[4];
#pragma unroll
                  for (int i = 0; i < 4; ++i) cb[i] = a[i]; }
                unsigned tp[4][4];
#pragma unroll
                for (int r = 0; r < 8; r += 2) {
                    float o0[4], o1[4];
#pragma unroll
                    for (int c = 0; c < 4; ++c) { o0[c] = cb[c]; o1[c] = cb[c]; }
#pragma unroll
                    for (int k = 0; k < 4; ++k) { const u32x2 a = raw[r + k], c2 = raw[r + 1 + k];
                        const float xa[4] = {bflo(a.x), bfhi(a.x), bflo(a.y), bfhi(a.y)};
                        const float xc[4] = {bflo(c2.x), bfhi(c2.x), bflo(c2.y), bfhi(c2.y)};
#pragma unroll
                        for (int c = 0; c < 4; ++c) { o0[c] += cw[k][c] * xa[c]; o1[c] += cw[k][c] * xc[c]; } }
                    const bool v0 = (seg * 8 + r) < T, v1 = (seg * 8 + r + 1) < T;
#pragma unroll
                    for (int c = 0; c < 4; ++c) { o0[c] = v0 ? o0[c] * sigmoidf_(o0[c]) : 0.f; o1[c] = v1 ? o1[c] * sigmoidf_(o1[c]) : 0.f; tp[c][r >> 1] = cvt_pk_bf16(o0[c], o1[c]); }
                    if (kind != 0) { lptr dst = (kind == 1 ? Bs : Cs) + (seg * 8 + r) * 272 + (ch4 & 127) * 2;
                        u32x2 w0, w1; w0.x = cvt_pk_bf16(o0[0], o0[1]); w0.y = cvt_pk_bf16(o0[2], o0[3]); w1.x = cvt_pk_bf16(o1[0], o1[1]); w1.y = cvt_pk_bf16(o1[2], o1[3]);
                        *(LAS u32x2*)dst = w0; *(LAS u32x2*)(dst + 272) = w1; }
                }
                if (kind != 2) { lptr dst = (kind == 0 ? (lds + L_HALF + sub * HALF_BYTES + LH_XT) + (ch4 & 63) * 144 : Bst + (ch4 & 127) * 144) + seg * 16;
#pragma unroll
                    for (int c = 0; c < 4; ++c) { u32x4 w; w.x = tp[c][0]; w.y = tp[c][1]; w.z = tp[c][2]; w.w = tp[c][3]; *(LAS u32x4*)(dst + c * 144) = w; } }
              }
            }
            __syncthreads();
            if (step + 1 < nsteps) { if (wv == 0) dtn = DTb[(R + 64 + lane) * 64 + h]; }
            u32x2 zz4[4];
            { const int l0 = 16 * wv + j, lz = l0 < T ? l0 : 0;
#pragma unroll
              for (int pt = 0; pt < 4; ++pt) zz4[pt] = *(const u32x2*)(ZX + (R + lz) * ZXW + h * 64 + 16 * pt + 4 * q); }
            const int l = 16 * wv + j; const float acl = acs[l], ac63 = acs[63];
            bf16x8 Cf[4];
#pragma unroll
            for (int kb = 0; kb < 4; ++kb) Cf[kb] = *(const LAS bf16x8*)(Cs + l * 272 + (32 * kb + 8 * q) * 2);
#pragma unroll
            for (int s4 = 0; s4 < 4; ++s4) { f32x4 a4 = {0.f, 0.f, 0.f, 0.f};
                if (s4 <= wv) {
#pragma unroll
                    for (int kb = 0; kb < 4; ++kb) { const bf16x8 bf = *(const LAS bf16x8*)(Bs + (16 * s4 + j) * 272 + (32 * kb + 8 * q) * 2); a4 = __builtin_amdgcn_mfma_f32_16x16x32_bf16(bf, Cf[kb], a4, 0, 0, 0); }
                    const f32x4 as = *(const LAS f32x4*)(acs + 16 * s4 + 4 * q), ds = *(const LAS f32x4*)(dts + 16 * s4 + 4 * q);
#pragma unroll
                    for (int i = 0; i < 4; ++i) { const int s = 16 * s4 + 4 * q + i; a4[i] = (s <= l) ? a4[i] * __expf(acl - as[i]) * ds[i] : 0.f; } }
                u32x2 w; w.x = cvt_pk_bf16(a4[0], a4[1]); w.y = cvt_pk_bf16(a4[2], a4[3]);
                *(LAS u32x2*)(Wl + l * 144 + (16 * s4 + 4 * q) * 2) = w; }
            LDS_FENCE();
            f32x4 Ya[4];
            { const float el = __expf(acl);
#pragma unroll
              for (int pt = 0; pt < 4; ++pt) { f32x4 yi = {0.f, 0.f, 0.f, 0.f};
#pragma unroll
                for (int kb = 0; kb < 4; ++kb) { const bf16x8 hf = *(const LAS bf16x8*)(Hs + (16 * pt + j) * 272 + (32 * kb + 8 * q) * 2); yi = __builtin_amdgcn_mfma_f32_16x16x32_bf16(hf, Cf[kb], yi, 0, 0, 0); }
                Ya[pt] = yi * el; } }
#pragma unroll
            for (int kb = 0; kb < 2; ++kb) { const bf16x8 wf = *(const LAS bf16x8*)(Wl + l * 144 + (32 * kb + 8 * q) * 2);
#pragma unroll
                for (int pt = 0; pt < 4; ++pt) { const bf16x8 xf = *(const LAS bf16x8*)(Xt + (16 * pt + j) * 144 + (32 * kb + 8 * q) * 2); Ya[pt] = __builtin_amdgcn_mfma_f32_16x16x32_bf16(xf, wf, Ya[pt], 0, 0, 0); } }
            if (l < T) {
#pragma unroll
                for (int pt = 0; pt < 4; ++pt) { const int p0 = 16 * pt + 4 * q; const u32x2 zz = zz4[pt];
                    const float zf[4] = {bflo(zz.x), bfhi(zz.x), bflo(zz.y), bfhi(zz.y)}; float y[4];
#pragma unroll
                    for (int i = 0; i < 4; ++i) { const float xv = __uint_as_float((unsigned)(*(const LAS unsigned short*)(Xt + (p0 + i) * 144 + l * 2)) << 16); y[i] = (Ya[pt][i] + dsk * xv) * zf[i] * sigmoidf_(zf[i]); }
                    u32x2 w; w.x = cvt_pk_bf16(y[0], y[1]); w.y = cvt_pk_bf16(y[2], y[3]); *(u32x2*)(Yg + (R + l) * DIN + h * 64 + p0) = w; }
            }
            { const float dec = __expf(ac63);
#pragma unroll
              for (int nt2 = 0; nt2 < 2; ++nt2)
#pragma unroll
                for (int pt = 0; pt < 4; ++pt) st[nt2][pt] *= dec;
#pragma unroll
              for (int kb = 0; kb < 2; ++kb) { float tl[8]; const f32x4 a0 = *(const LAS f32x4*)(acs + 32 * kb + 8 * q), a1 = *(const LAS f32x4*)(acs + 32 * kb + 8 * q + 4), d0 = *(const LAS f32x4*)(dts + 32 * kb + 8 * q), d1 = *(const LAS f32x4*)(dts + 32 * kb + 8 * q + 4);
#pragma unroll
                for (int i = 0; i < 4; ++i) { tl[i] = __expf(ac63 - a0[i]) * d0[i]; tl[4 + i] = __expf(ac63 - a1[i]) * d1[i]; }
                bf16x8 bfr[2];
#pragma unroll
                for (int nt2 = 0; nt2 < 2; ++nt2) bfr[nt2] = *(const LAS bf16x8*)(Bst + (16 * (2 * wv + nt2) + j) * 144 + (32 * kb + 8 * q) * 2);
#pragma unroll
                for (int pt = 0; pt < 4; ++pt) { const bf16x8 xs = scale8(*(const LAS bf16x8*)(Xt + (16 * pt + j) * 144 + (32 * kb + 8 * q) * 2), tl);
#pragma unroll
                    for (int nt2 = 0; nt2 < 2; ++nt2) st[nt2][pt] = __builtin_amdgcn_mfma_f32_16x16x32_bf16(bfr[nt2], xs, st[nt2][pt], 0, 0, 0); } } }
            __syncthreads();
#pragma unroll
            for (int nt2 = 0; nt2 < 2; ++nt2)
#pragma unroll
                for (int pt = 0; pt < 4; ++pt) { u32x2 w; w.x = cvt_pk_bf16(st[nt2][pt][0], st[nt2][pt][1]); w.y = cvt_pk_bf16(st[nt2][pt][2], st[nt2][pt][3]);
                    *(LAS u32x2*)(Hs + (16 * pt + j) * 272 + (16 * (2 * wv + nt2) + 4 * q) * 2) = w; }
        }
        float* so = P.out + (smp ? O_SSMS + (((size_t)jj * 32 + b) * 64 + h) * 8192 : O_SSMP + (((size_t)jj * 8 + b) * 64 + h) * 8192);
#pragma unroll
        for (int nt2 = 0; nt2 < 2; ++nt2)
#pragma unroll
            for (int pt = 0; pt < 4; ++pt) *(f32x4*)(so + (16 * pt + j) * 128 + 16 * (2 * wv + nt2) + 4 * q) = st[nt2][pt];
        __syncthreads();
#undef SSD_LOAD_RAW
    }
}
__device__ __forceinline__ void gnorm_phase(const Params& P, int jj, bf16_t* Yg, const bf16_t* ZX) {
    const int lane = threadIdx.x & 63, gw = blockIdx.x * 8 + (threadIdx.x >> 6), nW = gridDim.x * 8;
    for (int idx = gw; idx < M * 8; idx += nW) {
        const int row = idx >> 3, gi = idx & 7; bf16_t* p = Yg + (size_t)row * DIN + gi * 512 + lane * 8;
        const u32x4 v = *(const u32x4*)p; float f[8] = {bflo(v.x), bfhi(v.x), bflo(v.y), bfhi(v.y), bflo(v.z), bfhi(v.z), bflo(v.w), bfhi(v.w)};
        float ss = 0.f;
#pragma unroll
        for (int i = 0; i < 8; ++i) ss += f[i] * f[i];
        ss = wave_sum(ss); const float r = __builtin_amdgcn_rsqf(ss * (1.0f / 512.0f) + EPS);
        const float* nw = P.in[24] + (size_t)jj * DIN + gi * 512 + lane * 8; const f32x4 w0 = *(const f32x4*)nw, w1 = *(const f32x4*)(nw + 4);
        u32x4 o; o.x = cvt_pk_bf16(f[0] * r * w0[0], f[1] * r * w0[1]); o.y = cvt_pk_bf16(f[2] * r * w0[2], f[3] * r * w0[3]); o.z = cvt_pk_bf16(f[4] * r * w1[0], f[5] * r * w1[1]); o.w = cvt_pk_bf16(f[6] * r * w1[2], f[7] * r * w1[3]);
        *(u32x4*)p = o;
    }
    const int gt = blockIdx.x * 512 + threadIdx.x, nTh = gridDim.x * 512;
    for (int e = gt; e < 40 * 3 * CONVD; e += nTh) {
        const int ch = e % CONVD, r = (e / CONVD) % 3, bb = e / (3 * CONVD);
        const size_t row = bb < 8 ? (size_t)bb * 4096 + 4093 + r : (size_t)MP + (bb - 8) * 16 + 13 + r;
        const float v = __uint_as_float((unsigned)ZX[row * ZXW + 4096 + ch] << 16);
        if (bb < 8) P.out[O_CONVP + (((size_t)jj * 8 + bb) * 3 + r) * CONVD + ch] = v; else P.out[O_CONVS + (((size_t)jj * 32 + (bb - 8)) * 3 + r) * CONVD + ch] = v;
    }
}

__global__ void __launch_bounds__(512, 2) fwd(Params P) {
    extern __shared__ __attribute__((aligned(16))) unsigned char shm[];
    lptr lds = (lptr)shm;
    if (threadIdx.x < 4) ((LAS unsigned*)(lds + LDS_BAR))[threadIdx.x] = 0u;
    __syncthreads();
    const int lo = P.ph_lo, hi = P.ph_hi;
    unsigned char* ws = P.ws;
    XcdBarrier bar; bar.bar = (unsigned*)(ws + WS_CTL); bar.x = 0; bar.st = (volatile LAS unsigned*)(lds + LDS_BAR);
    if (hi - lo > 1) bar = xcd_barrier_post((unsigned*)(ws + WS_CTL), (volatile LAS unsigned*)(lds + LDS_BAR));
    float* X = P.out;
    bf16_t* A = (bf16_t*)(ws + WS_R1); bf16_t* G2 = A + (size_t)M * D; bf16_t* R2 = (bf16_t*)(ws + WS_R2); float* DTb = (float*)(ws + WS_DT);
    float* PART = (float*)(ws + WS_PART); bf16_t* WA = (bf16_t*)(ws + WS_WA); bf16_t* WB = (bf16_t*)(ws + WS_WB); bf16_t* W1 = (bf16_t*)(ws + WS_W1); bf16_t* W2 = (bf16_t*)(ws + WS_W2);
    const int G = gridDim.x, c = blockIdx.x;
#define RUN(k) (lo <= (k) && (k) < hi)
#define SEAM(k) do { if ((k) + 1 < hi) xcd_barrier(bar); } while (0)
#ifdef NO_S5
#define S5_CALL
#else
#define S5_CALL s5_phase(P, jx, A, G2, lds)
#endif
#ifdef NO_SSD
#define SSD_CALL
#else
#define SSD_CALL ssd_phase(P, jx, R2, DTb, A, lds)
#endif
#define LAYER(i) { \
        const int jx = i >> 1, pb = i * 8; \
        if ((i & 1) == 0) { \
            if (RUN(pb + 0)) { \
                convert_wt(P.in[17] + (size_t)jx * D * 4096, D, 4096, WA, 4096, 1, lds); \
                convert_wt(P.in[26] + (size_t)i * D * DFF, D, DFF, W1, DFF, 0, lds); \
                convert_wt(P.in[27] + (size_t)i * DFF * D, DFF, D, W2, D, 0, lds); \
                if (i == 0) rms_phase<1>(P.in[0], P.in[1], X, P.in[6] + (size_t)i * D, A); else rms_phase<0>(nullptr, nullptr, X, P.in[6] + (size_t)i * D, A, PART); \
                SEAM(pb + 0); } \
            if (RUN(pb + 1)) { \
 S5_CALL; \
 SEAM(pb + 1); } \
            if (RUN(pb + 2)) { pg8::Gemm g{G2, WA, M, 4096, D}; pg8::StaticOrder S; S.init(M, 4096, G, c); EpiGlu E{X, i == 0 ? P.in[0] : X, i == 0 ? P.in[1] : X + (size_t)MP * D}; pg8::gemm_phase<EpiGlu, pg8::StaticOrder, false>(lds, g, S, E, nullptr); SEAM(pb + 2); } \
        } else { \
            if (RUN(pb + 0)) { \
                convert_wt(P.in[18] + (size_t)jx * D * NPROJ, D, NPROJ, WA, NPROJ_PAD, 2, lds); \
                convert_wt(P.in[25] + (size_t)jx * DIN * D, DIN, D, WB, D, 0, lds); \
                convert_wt(P.in[26] + (size_t)i * D * DFF, D, DFF, W1, DFF, 0, lds); \
                convert_wt(P.in[27] + (size_t)i * DFF * D, DFF, D, W2, D, 0, lds); \
                rms_phase<0>(nullptr, nullptr, X, P.in[6] + (size_t)i * D, A, PART); \
                SEAM(pb + 0); } \
            if (RUN(pb + 1)) { pg8::Gemm g{A, WA, M, NPROJ_PAD, D}; pg8::StaticOrder S; S.init(M, NPROJ_PAD, G, c); EpiSsdIn E{R2, DTb}; pg8::gemm_phase<EpiSsdIn, pg8::StaticOrder, false>(lds, g, S, E, nullptr); SEAM(pb + 1); } \
            if (RUN(pb + 2)) { \
 SSD_CALL; \
 SEAM(pb + 2); } \
            if (RUN(pb + 3)) { gnorm_phase(P, jx, A, R2); SEAM(pb + 3); } \
            if (RUN(pb + 4)) { { pg8::Gemm g{A, WB, MP, D, DIN, DIN}; pg8::StaticOrder S; S.init(MP, D, G, c); EpiAdd E{X}; pg8::gemm_phase<EpiAdd, pg8::StaticOrder, false>(lds, g, S, E, nullptr); } { pg8::Gemm g{A, WB, M, D, DIN / 16, DIN}; TailOrder S{8, 16, DIN / 16, G, c}; EpiPartial E{PART, DIN / 16}; pg8::gemm_phase<EpiPartial, TailOrder, false>(lds, g, S, E, nullptr); } SEAM(pb + 4); } \
        } \
        if (RUN(pb + 5)) { rms_phase<0>(nullptr, nullptr, X, P.in[7] + (size_t)i * D, A, (i & 1) ? PART : nullptr); SEAM(pb + 5); } \
        if (RUN(pb + 6)) { pg8::Gemm g{A, W1, M, DFF, D}; pg8::StaticOrder S; S.init(M, DFF, G, c); EpiRelu2 E{R2}; pg8::gemm_phase<EpiRelu2, pg8::StaticOrder, false>(lds, g, S, E, nullptr); SEAM(pb + 6); } \
        if (RUN(pb + 7)) { { pg8::Gemm g{R2, W2, MP, D, DFF, DFF}; pg8::StaticOrder S; S.init(MP, D, G, c); EpiAdd E{X}; pg8::gemm_phase<EpiAdd, pg8::StaticOrder, false>(lds, g, S, E, nullptr); } { pg8::Gemm g{R2, W2, M, D, DFF / 16, DFF}; TailOrder S{8, 16, DFF / 16, G, c}; EpiPartial E{PART, DFF / 16}; pg8::gemm_phase<EpiPartial, TailOrder, false>(lds, g, S, E, nullptr); } SEAM(pb + 7); } \
}
    LAYER(0) LAYER(1) LAYER(2) LAYER(3)
    if (RUN(32)) rms_phase<2>(nullptr, nullptr, X, P.in[8], nullptr, PART);
}

#ifndef BISECT
#define BISECT 0
#endif
#ifndef N_LAUNCH_PER_PHASE
#define N_LAUNCH_PER_PHASE 0
#endif
extern "C" void kernel_launch(void* const* d_in, const int* in_sizes, int n_in, void* d_out, int out_size, void* d_ws, size_t ws_size, hipStream_t stream) {
    static int grid = 0;
    if (grid == 0) {
        if (n_in != 28 || ws_size < WS_END) { fprintf(stderr, "kernel_launch: need 28 inputs and %zu bytes of workspace; got %d, %zu\n", (size_t)WS_END, n_in, ws_size); grid = -1; return; }
        int dev = 0, cus = 0, per_cu = 0;
        if (hipGetDevice(&dev) != hipSuccess || hipDeviceGetAttribute(&cus, hipDeviceAttributeMultiprocessorCount, dev) != hipSuccess) { grid = -1; return; }
        if (hipFuncSetAttribute((const void*)fwd, hipFuncAttributeMaxDynamicSharedMemorySize, LDS_BYTES) != hipSuccess) { fprintf(stderr, "kernel_launch: hipFuncSetAttribute failed\n"); grid = -1; return; }
        if (hipOccupancyMaxActiveBlocksPerMultiprocessor(&per_cu, (const void*)fwd, 512, LDS_BYTES) != hipSuccess || per_cu < 1) fprintf(stderr, "kernel_launch: occupancy query says %d\n", per_cu);
        (void)hipGetLastError();
        grid = cus < 256 ? cus : 256;
    }
    if (grid < 0) return;
    (void)hipMemsetAsync((char*)d_ws + WS_CTL, 0, 16384, stream);
    Params p{};
    for (int i = 0; i < 28; ++i) p.in[i] = (const float*)d_in[i];
    p.out = (float*)d_out; p.ws = (unsigned char*)d_ws;
#if N_LAUNCH_PER_PHASE
    for (int k = 0; k <= 32; ++k) { const int s = k & 7; if (k < 32 && (((k >> 3) & 1) == 0) && (s == 3 || s == 4)) continue;
#if BISECT == 1
        if (k < 32 && (((k >> 3) & 1) == 1) && s >= 1 && s <= 4) continue;
#elif BISECT == 3
        if (k < 32 && (((k >> 3) & 1) == 1) && s >= 2 && s <= 3) continue;
#elif BISECT == 4
        if (k < 32 && (((k >> 3) & 1) == 1) && s == 3) continue;
#elif BISECT == 2
        if (k < 32 && (((k >> 3) & 1) == 0) && s >= 1 && s <= 2) continue;
#endif
 p.ph_lo = k; p.ph_hi = k + 1; hipLaunchKernelGGL(fwd, dim3(grid), dim3(512), LDS_BYTES, stream, p); }
#else
    p.ph_lo = 0; p.ph_hi = 33;
    hipLaunchKernelGGL(fwd, dim3(grid), dim3(512), LDS_BYTES, stream, p);
#endif
    const hipError_t le = hipPeekAtLastError();
    if (le != hipSuccess) fprintf(stderr, "kernel_launch: launch failed: %s\n", hipGetErrorName(le));
}
```

```cpp
#include <hip/hip_runtime.h>
#include <cstdio>
#include <cstdint>
#define XB_TMO      128
#define XB_XCNT(j)  (256  + 64 * (j))
#define XB_XSUB(j)  (1280 + 64 * (j))
#define XB_XGEN(j)  (2304 + 64 * (j))
#define XB_TOP      3328
#define XB_TOPGEN   3392
#define XCD_BAR_WORDS 3456
#define XB_SPIN_CAP (1u << 18)
#define LAS __attribute__((address_space(3)))

__device__ __forceinline__ unsigned xb_ld(unsigned* p)              { return __hip_atomic_load(p, __ATOMIC_RELAXED, __HIP_MEMORY_SCOPE_AGENT); }
__device__ __forceinline__ unsigned xb_add(unsigned* p, unsigned v) { return __hip_atomic_fetch_add(p, v, __ATOMIC_RELAXED, __HIP_MEMORY_SCOPE_AGENT); }
__device__ __forceinline__ unsigned xb_xcc_id() { return (unsigned)__builtin_amdgcn_s_getreg((3 << 11) | 20) & 0xFu; }
#define XB_SPIN(cond, bar) do { unsigned _sp = 0; while (cond) { __builtin_amdgcn_s_sleep(1); \
    if ((++_sp & 255u) == 0u) { if (xb_ld(&(bar)[XB_TMO])) break; if (_sp > XB_SPIN_CAP) { atomicAdd(&(bar)[XB_TMO], 1u); break; } } } } while (0)

struct XcdBarrier {
    unsigned* bar; unsigned x;
    volatile LAS unsigned* st;
};

__device__ __forceinline__ XcdBarrier xcd_barrier_post(unsigned* bar, volatile LAS unsigned* st) {
    XcdBarrier b; b.bar = bar; b.x = xb_xcc_id(); b.st = st;
    if (threadIdx.x == 0) (void)xb_add(&bar[XB_XCNT(b.x)], 1u);
    return b;
}
__device__ __forceinline__ void xcd_barrier_complete(unsigned* bar, unsigned x, unsigned& nloc, unsigned& nx) {
    const unsigned G = gridDim.x * gridDim.y * gridDim.z;
    unsigned sum, cnt, mine, sp = 0u;
    for (;;) {
        sum = 0u; cnt = 0u; mine = 0u;
#pragma unroll
        for (unsigned j = 0; j < 16; ++j) { const unsigned c = xb_ld(&bar[XB_XCNT(j)]); sum += c; cnt += (c > 0u) ? 1u : 0u; mine = (j == x) ? c : mine; }
        if (sum == G) break;
        __builtin_amdgcn_s_sleep(1);
        if ((++sp & 255u) == 0u) { if (xb_ld(&bar[XB_TMO])) break; if (sp > XB_SPIN_CAP) { atomicAdd(&bar[XB_TMO], 1u); break; } }
    }
    nloc = mine > 0u ? mine : 1u; nx = cnt > 0u ? cnt : 1u;
}

__device__ __forceinline__ void xcd_barrier(const XcdBarrier& b) {
    asm volatile("s_waitcnt vmcnt(0)" ::: "memory");
    __syncthreads();
    if (threadIdx.x == 0) {
        unsigned* bar = b.bar;
        __builtin_amdgcn_s_waitcnt(0);
        unsigned nloc = b.st[0], nx = b.st[1];
        if (nloc == 0u) { xcd_barrier_complete(bar, b.x, nloc, nx); b.st[0] = nloc; b.st[1] = nx; }
        const unsigned old = xb_add(&bar[XB_XSUB(b.x)], 1u);
        const unsigned gen = old / nloc;
        if (old + 1u == (gen + 1u) * nloc) {
            __builtin_amdgcn_fence(__ATOMIC_RELEASE, "agent");
            asm volatile("s_waitcnt vmcnt(0)" ::: "memory");
            const unsigned og = xb_add(&bar[XB_TOP], 1u);
            const unsigned tg = og / nx;
            if (og + 1u == (tg + 1u) * nx) xb_add(&bar[XB_TOPGEN], 1u);
            else XB_SPIN(xb_ld(&bar[XB_TOPGEN]) == tg, bar);
            __builtin_amdgcn_fence(__ATOMIC_ACQUIRE, "agent");
            xb_add(&bar[XB_XGEN(b.x)], 1u);
            asm volatile("s_waitcnt vmcnt(0)" ::: "memory");
        } else {
            XB_SPIN(xb_ld(&bar[XB_XGEN(b.x)]) == gen, bar);
            __builtin_amdgcn_fence(__ATOMIC_ACQUIRE, "agent");
            asm volatile("s_waitcnt vmcnt(0)" ::: "memory");
        }
    }
    __syncthreads();
}
namespace pg8 {
#define PG8_LAS __attribute__((address_space(3)))
typedef unsigned short bf16_t;
typedef short bf16x8 __attribute__((ext_vector_type(8)));
typedef float f32x4 __attribute__((ext_vector_type(4)));
typedef unsigned u32x4 __attribute__((ext_vector_type(4)));
constexpr int BM = 256, BK = 64, HALF = 128, HTB = HALF * BK * 2  , STAGE_BYTES = 8 * HTB, NXCD = 8, WGM = 8;

__host__ __device__ __forceinline__ int lds_byte(int r, int c) { const int st = (r >> 4) * 2 + (c >> 5), rr = r & 15, cc = c & 31, ob = rr * 64 + cc * 2; return st * 1024 + (ob ^ (((ob >> 9) & 1) << 5)); }
__host__ __device__ __forceinline__ void stage_rc(int b, int& R, int& C) { const int st = b / 1024, sb = b % 1024, swz = sb ^ (((sb >> 9) & 1) << 5); R = (st >> 1) * 16 + swz / 64; C = (st & 1) * 32 + (swz % 64) / 2; }
__host__ __device__ __forceinline__ int perm32(int rho) { const int n = rho >> 4, i = rho & 15; return 8 * (i >> 2) + 4 * n + (i & 3); }

struct Unit { int pm, pn, koff; };
struct Gemm { const bf16_t* A; const bf16_t* Bt; int M, N, K, ld; };
struct StaticOrder {
    int nM, nN, nwg, G, c;
    __host__ __device__ void init(int M, int N, int G_, int c_) { nM = M / BM; nN = N / BM; nwg = nM * nN; G = G_; c = c_; }
    __host__ __device__ bool next(int i, Unit& u) const {
        const long L = (long)i * G + c; if (L >= nwg) return false;
        int wgid = (int)L; { const int q = nwg / NXCD, r = nwg % NXCD, xcd = wgid % NXCD, off = wgid / NXCD; wgid = (xcd < r ? xcd * (q + 1) : r * (q + 1) + (xcd - r) * q) + off; }
        const int nig = WGM * nN, gid = wgid / nig, fm = gid * WGM, gsz = (nM - fm) < WGM ? (nM - fm) : WGM;
        u.pm = fm + ((wgid % nig) % gsz); u.pn = (wgid % nig) / gsz; u.koff = 0; return true;
    }
    __device__ __forceinline__ void a_ready(const Unit&) const {}
    __device__ __forceinline__ void done(const Unit&) const {}
};
typedef float f32x2c __attribute__((ext_vector_type(2))); typedef __bf16 bf16x2c __attribute__((ext_vector_type(2)));
__device__ __forceinline__ unsigned cvt_pk_bf16(float lo, float hi) { const f32x2c v = {lo, hi}; return __builtin_bit_cast(unsigned, __builtin_convertvector(v, bf16x2c)); }
template <class Epi, class Sched, bool STAMP = false>
__device__ __forceinline__ void gemm_phase(PG8_LAS unsigned char* lds, const Gemm g, const Sched& S, const Epi& E, unsigned long long* stamps) {
    const int tid = threadIdx.x, wid = __builtin_amdgcn_readfirstlane(tid >> 6), lane = tid & 63, wr = wid >> 2, wc = wid & 3, fr = lane & 15, fq = lane >> 4;
    const int K = g.K, nt = K / BK, LD = g.ld ? g.ld : g.K;
    int ts_lo = 0, ts_hi = 0, nts = 0; const unsigned long long rt_entry = STAMP ? (unsigned long long)wall_clock64() : 0ull;
#define PG8_STAMP() do { if (STAMP && wid == 0 && nts < 64) { const unsigned long long _c = (unsigned long long)clock64(); \
        ts_lo = (lane == nts) ? (int)(unsigned)_c : ts_lo; ts_hi = (lane == nts) ? (int)(unsigned)(_c >> 32) : ts_hi; ++nts; } } while (0)
    PG8_STAMP();
    unsigned voffA[2], voffB[2];
#pragma unroll
    for (int i = 0; i < 2; ++i) { int R, C; stage_rc(tid * 16 + i * 8192, R, C); const int Rb = Epi::PERM ? ((R & ~31) + perm32(R & 31)) : R;
        voffA[i] = (unsigned)(R * LD + C) * 2u; voffB[i] = (unsigned)(Rb * LD + C) * 2u; }
    const size_t kstep = (size_t)(BK * 2);
    const size_t hstep = (size_t)HALF * LD * 2;
    const size_t tstep = 2 * hstep;
    const unsigned ldsw = (unsigned)wid * 1024u;
    const int aoff = lds_byte(wr * 64 + fr, fq * 8), boff = lds_byte(wc * 32 + fr, fq * 8);
#define PG8_SA(b, h) (((b) * 2 + (h)) * HTB)
#define PG8_SB(b, h) ((4 + (b) * 2 + (h)) * HTB)
#define PG8_STAGE(bufoff, gbase, voff) do { _Pragma("unroll") for (int _i = 0; _i < 2; ++_i) \
        __builtin_amdgcn_global_load_lds((const unsigned*)((const char*)(gbase) + (voff)[_i]), (PG8_LAS unsigned*)(lds + (bufoff) + ldsw + _i * 8192), 16, 0, 0); } while (0)
#define PG8_LDA(dst, b, h) do { _Pragma("unroll") for (int m = 0; m < 4; ++m) _Pragma("unroll") for (int k = 0; k < 2; ++k) dst[m][k] = *(const PG8_LAS bf16x8*)(lds + PG8_SA(b, h) + aoff + m * 2048 + k * 1024); } while (0)
#define PG8_LDB(dst, b, h) do { _Pragma("unroll") for (int n = 0; n < 2; ++n) _Pragma("unroll") for (int k = 0; k < 2; ++k) dst[n][k] = *(const PG8_LAS bf16x8*)(lds + PG8_SB(b, h) + boff + n * 2048 + k * 1024); } while (0)
#define PG8_MMA(ai, bj, At, Bt) do { __builtin_amdgcn_s_setprio(1); _Pragma("unroll") for (int m = 0; m < 4; ++m) _Pragma("unroll") for (int n = 0; n < 2; ++n) _Pragma("unroll") for (int k = 0; k < 2; ++k) \
        acc[ai][bj][m][n] = __builtin_amdgcn_mfma_f32_16x16x32_bf16(Bt[n][k], At[m][k], acc[ai][bj][m][n], 0, 0, 0); __builtin_amdgcn_s_setprio(0); } while (0)
#define PG8_WAIT_V(n) asm volatile("s_waitcnt vmcnt(" #n ")" ::: "memory")
#define PG8_WAIT_L(n) asm volatile("s_waitcnt lgkmcnt(" #n ")" ::: "memory")
#define PG8_BAR __builtin_amdgcn_s_barrier()
#define PG8_SCHED __builtin_amdgcn_sched_barrier(0)
    Unit cur, nxt; int ui = 0;
    if (!S.next(0, cur)) return;
    f32x4 acc[2][2][4][2];
#pragma unroll
    for (int a = 0; a < 2; ++a)
#pragma unroll
        for (int b = 0; b < 2; ++b)
#pragma unroll
            for (int m = 0; m < 4; ++m)
#pragma unroll
                for (int n = 0; n < 2; ++n) acc[a][b][m][n] = (f32x4){0.f, 0.f, 0.f, 0.f};
    bf16x8 At[4][2], B0[2][2], B1[2][2];
    const char* cA = (const char*)g.A + (size_t)cur.pm * tstep + (size_t)cur.koff * 2; const char* cB = (const char*)g.Bt + (size_t)cur.pn * tstep + (size_t)cur.koff * 2;
    S.a_ready(cur);
    PG8_STAGE(PG8_SB(0, 0), cB, voffB); PG8_STAGE(PG8_SA(0, 0), cA, voffA); PG8_STAGE(PG8_SB(0, 1), cB + hstep, voffB); PG8_STAGE(PG8_SA(0, 1), cA + hstep, voffA);
    if (wr == 1) PG8_BAR;
    PG8_WAIT_V(4); PG8_BAR;
    PG8_STAGE(PG8_SB(1, 0), cB + kstep, voffB); PG8_STAGE(PG8_SA(1, 0), cA + kstep, voffA); PG8_STAGE(PG8_SB(1, 1), cB + hstep + kstep, voffB);
    PG8_WAIT_V(6); PG8_BAR;
    PG8_STAMP();
    for (;;) {
        const bool has_next = S.next(ui + 1, nxt);
        const char* nA = has_next ? (const char*)g.A + (size_t)nxt.pm * tstep + (size_t)nxt.koff * 2 : cA; const char* nB = has_next ? (const char*)g.Bt + (size_t)nxt.pn * tstep + (size_t)nxt.koff * 2 : cB;
        for (int t = 0; t < nt; t += 2) {
            const bool last = (t == nt - 2);
            const char* a1 = cA + (size_t)(t + 1) * kstep;
            const char* a2 = last ? nA : cA + (size_t)(t + 2) * kstep; const char* b2 = last ? nB : cB + (size_t)(t + 2) * kstep;
            const char* a3 = a2 + kstep; const char* b3 = b2 + kstep;
            if (last && has_next) S.a_ready(nxt);
            PG8_LDB(B0, 0, 0); PG8_SCHED; PG8_LDA(At, 0, 0); PG8_STAGE(PG8_SA(1, 1), a1 + hstep, voffA);
            PG8_WAIT_L(8); PG8_BAR; PG8_WAIT_L(0); PG8_MMA(0, 0, At, B0); PG8_BAR; PG8_SCHED;
            PG8_LDB(B1, 0, 1); PG8_STAGE(PG8_SB(0, 0), b2, voffB);
            PG8_BAR; PG8_WAIT_L(0); PG8_MMA(0, 1, At, B1); PG8_BAR;
            PG8_LDA(At, 0, 1); PG8_STAGE(PG8_SA(0, 0), a2, voffA);
            PG8_BAR; PG8_WAIT_L(0); PG8_MMA(1, 0, At, B0); PG8_BAR; PG8_SCHED;
            PG8_STAGE(PG8_SB(0, 1), b2 + hstep, voffB);
            PG8_WAIT_V(6); PG8_BAR; PG8_MMA(1, 1, At, B1); PG8_BAR;
            PG8_LDB(B0, 1, 0); PG8_SCHED; PG8_LDA(At, 1, 0); PG8_STAGE(PG8_SA(0, 1), a2 + hstep, voffA);
            PG8_WAIT_L(8); PG8_BAR; PG8_WAIT_L(0); PG8_MMA(0, 0, At, B0); PG8_BAR; PG8_SCHED;
            PG8_LDB(B1, 1, 1); PG8_STAGE(PG8_SB(1, 0), b3, voffB);
            PG8_BAR; PG8_WAIT_L(0); PG8_MMA(0, 1, At, B1); PG8_BAR;
            PG8_LDA(At, 1, 1); PG8_STAGE(PG8_SA(1, 0), a3, voffA);
            PG8_BAR; PG8_WAIT_L(0); PG8_MMA(1, 0, At, B0); PG8_BAR; PG8_SCHED;
            PG8_STAGE(PG8_SB(1, 1), b3 + hstep, voffB);
            PG8_WAIT_V(6); PG8_BAR; PG8_MMA(1, 1, At, B1); PG8_BAR;
        }
        PG8_STAMP();
        if constexpr (!Epi::AFTER_DRAIN) { E(acc, cur, wr, wc, fr, fq); S.done(cur); }
        PG8_STAMP();
        if (!has_next) break;
#pragma unroll
        for (int a = 0; a < 2; ++a)
#pragma unroll
            for (int b = 0; b < 2; ++b)
#pragma unroll
                for (int m = 0; m < 4; ++m)
#pragma unroll
                    for (int n = 0; n < 2; ++n) acc[a][b][m][n] = (f32x4){0.f, 0.f, 0.f, 0.f};
        cur = nxt; cA = nA; cB = nB; ++ui;
    }
    PG8_WAIT_V(0);
    if (wr == 0) PG8_BAR;
    PG8_BAR;
    if constexpr (Epi::AFTER_DRAIN) { E.fused(acc, cur, wr, wc, fr, fq, lds, wid, lane); S.done(cur); }
    PG8_STAMP();
    if (STAMP && wid == 0) { stamps[lane] = lane < nts ? (((unsigned long long)(unsigned)ts_hi << 32) | (unsigned)ts_lo) : 0ull;
        if (lane == 62) stamps[62] = rt_entry; if (lane == 63) stamps[63] = (unsigned long long)wall_clock64(); }
#undef PG8_STAMP
#undef PG8_SA
#undef PG8_SB
#undef PG8_STAGE
#undef PG8_LDA
#undef PG8_LDB
#undef PG8_MMA
#undef PG8_WAIT_V
#undef PG8_WAIT_L
#undef PG8_BAR
#undef PG8_SCHED
}
}
using pg8::bf16_t; using pg8::bf16x8; using pg8::f32x4; using pg8::u32x4; using pg8::cvt_pk_bf16; using pg8::Unit;
typedef unsigned u32x2 __attribute__((ext_vector_type(2)));
typedef float f32x2v __attribute__((ext_vector_type(2)));
typedef LAS unsigned char* lptr;
constexpr int D = 2048, MP = 32768, MS = 512, M = MP + MS, DFF = 8192, DIN = 4096, CONVD = 6144, NPROJ = 10304, NPROJ_PAD = 10496, ZXW = 10240;
constexpr float EPS = 1e-5f;
constexpr size_t WS_CTL = 0, WS_R1 = 16384, R1_BYTES = (size_t)M * 4096 * 2, WS_R2 = WS_R1 + R1_BYTES, R2_BYTES = (size_t)M * ZXW * 2, WS_DT = WS_R2 + R2_BYTES, DT_BYTES = (size_t)M * 64 * 4,
                 WS_WA = WS_DT + DT_BYTES, WA_BYTES = (size_t)NPROJ_PAD * D * 2, WS_WB = WS_WA + WA_BYTES, WB_BYTES = (size_t)D * DIN * 2, WS_W1 = WS_WB + WB_BYTES, W1_BYTES = (size_t)DFF * D * 2,
                 WS_W2 = WS_W1 + W1_BYTES, WS_PART = WS_W2 + W1_BYTES, WS_END = WS_PART + (size_t)16 * MS * D * 4;
constexpr size_t O_YP = 0, O_YS = 67108864, O_S5RP = 68157440, O_S5IP = 68288512, O_CONVP = 68419584, O_SSMP = 68714496, O_S5RS = 77103104, O_S5IS = 77627392, O_CONVS = 78151680, O_SSMS = 79331328;
constexpr int LDS_BAR = 131072, LDS_BYTES = 147456;
struct Params { const float* in[28]; float* out; unsigned char* ws; int ph_lo, ph_hi; };

__device__ __forceinline__ float bflo(unsigned w) { return __uint_as_float(w << 16); }
__device__ __forceinline__ float bfhi(unsigned w) { return __uint_as_float(w & 0xffff0000u); }
__device__ __forceinline__ float wave_sum(float v) { for (int o = 32; o > 0; o >>= 1) v += __shfl_xor(v, o); return v; }
__device__ __forceinline__ float sigmoidf_(float x) { return __builtin_amdgcn_rcpf(1.0f + __expf(-x)); }
#define LDS_FENCE() asm volatile("s_waitcnt lgkmcnt(0)" ::: "memory")

__device__ __forceinline__ void convert_wt(const float* src, int K, int Nsrc, bf16_t* dst, int Npad, int mode, lptr lds) {
    const int tid = threadIdx.x, nkt = K / 64, nT = (Npad / 64) * nkt, kr = tid >> 4, c4 = (tid & 15) * 4, G = gridDim.x;
    f32x4 v0 = {0.f, 0.f, 0.f, 0.f}, v1 = v0;
#define CW_LOAD(tt) do { const int kt_ = (tt) % nkt, n0_ = ((tt) / nkt) * 64, k0_ = kt_ * 64; int col0_ = n0_; \
        if (mode == 1) { const int pn_ = n0_ >> 8, r_ = n0_ & 255; col0_ = (r_ >> 7) * 2048 + pn_ * 128 + (r_ & 127); } \
        if (mode == 2 && n0_ >= Nsrc) col0_ = -1; \
        if (col0_ >= 0) { v0 = *(const f32x4*)(src + (size_t)(k0_ + kr) * Nsrc + col0_ + c4); v1 = *(const f32x4*)(src + (size_t)(k0_ + kr + 32) * Nsrc + col0_ + c4); } \
        else { v0 = (f32x4){0.f, 0.f, 0.f, 0.f}; v1 = v0; } } while (0)
    int t = blockIdx.x, buf = 0;
    if (t < nT) CW_LOAD(t);
    for (; t < nT; t += G) {
        const f32x4 c0 = v0, c1 = v1; const int kt = t % nkt, n0 = (t / nkt) * 64, k0 = kt * 64;
        if (t + G < nT) CW_LOAD(t + G);
        LAS float* L = (LAS float*)(lds + buf * 16640);
#pragma unroll
        for (int i = 0; i < 4; ++i) { L[kr * 65 + c4 + i] = c0[i]; L[(kr + 32) * 65 + c4 + i] = c1[i]; }
        __syncthreads();
        const int n = tid >> 3, k8 = (tid & 7) * 8; float f[8];
#pragma unroll
        for (int i = 0; i < 8; ++i) f[i] = L[(k8 + i) * 65 + n];
        u32x4 w; w.x = cvt_pk_bf16(f[0], f[1]); w.y = cvt_pk_bf16(f[2], f[3]); w.z = cvt_pk_bf16(f[4], f[5]); w.w = cvt_pk_bf16(f[6], f[7]);
        *(u32x4*)(dst + (size_t)(n0 + n) * K + k0 + k8) = w;
        buf ^= 1;
    }
#undef CW_LOAD
    __syncthreads();
}

template <int MODE> __device__ __forceinline__ void rms_phase(const float* xp, const float* xs, float* X, const float* gain, bf16_t* A, const float* Pp = nullptr) {
    const int lane = threadIdx.x & 63, gw = blockIdx.x * 8 + (threadIdx.x >> 6), nW = gridDim.x * 8;
    f32x4 g[8];
#pragma unroll
    for (int i = 0; i < 8; ++i) g[i] = *(const f32x4*)(gain + i * 256 + lane * 4);
    for (int row = gw; row < M; row += nW) {
        const float* src = (MODE == 1) ? (row < MP ? xp + (size_t)row * D : xs + (size_t)(row - MP) * D) : X + (size_t)row * D;
        f32x4 v[8]; float ss = 0.f;
#pragma unroll
        for (int i = 0; i < 8; ++i) v[i] = *(const f32x4*)(src + i * 256 + lane * 4);
        if (MODE != 1 && Pp != nullptr && row >= MP) {
#pragma unroll 1
            for (int ks = 0; ks < 16; ++ks) { const float* pp = Pp + ((size_t)ks * MS + (row - MP)) * D + lane * 4;
#pragma unroll
                for (int i = 0; i < 8; ++i) v[i] += *(const f32x4*)(pp + i * 256); }
            if (MODE == 0) {
#pragma unroll
                for (int i = 0; i < 8; ++i) *(f32x4*)(X + (size_t)row * D + i * 256 + lane * 4) = v[i]; }
        }
#pragma unroll
        for (int i = 0; i < 8; ++i) ss += v[i][0] * v[i][0] + v[i][1] * v[i][1] + v[i][2] * v[i][2] + v[i][3] * v[i][3];
        ss = wave_sum(ss);
        const float r = __builtin_amdgcn_rsqf(ss * (1.0f / D) + EPS);
#pragma unroll
        for (int i = 0; i < 8; ++i) {
            const f32x4 y = v[i] * r * g[i];
            if (MODE == 2) *(f32x4*)(X + (size_t)row * D + i * 256 + lane * 4) = y;
            else { u32x2 w; w.x = cvt_pk_bf16(y[0], y[1]); w.y = cvt_pk_bf16(y[2], y[3]); *(u32x2*)(A + (size_t)row * D + i * 256 + lane * 4) = w;
                 }
        }
    }
}

struct EpiGlu {
    static constexpr bool PERM = false, AFTER_DRAIN = false; float* X; const float* rp; const float* rs;
    __device__ __forceinline__ void operator()(const f32x4 (&acc)[2][2][4][2], const Unit& u, int wr, int wc, int fr, int fq) const {
        const int row0 = u.pm * 256 + wr * 64 + fr, col0 = u.pn * 128 + wc * 32 + 4 * fq;
        const float* rsrc = u.pm < 128 ? rp : rs - (size_t)MP * D;
#pragma unroll
        for (int ai = 0; ai < 2; ++ai)
#pragma unroll
            for (int m = 0; m < 4; ++m) { float* rowp = X + (size_t)(row0 + ai * 128 + m * 16) * D + col0; const float* srcp = rsrc + (size_t)(row0 + ai * 128 + m * 16) * D + col0;
#pragma unroll
                for (int n = 0; n < 2; ++n) { f32x4 x = *(const f32x4*)(srcp + n * 16); const f32x4 a = acc[ai][0][m][n], b = acc[ai][1][m][n];
#pragma unroll
                    for (int j = 0; j < 4; ++j) x[j] += a[j] * sigmoidf_(b[j]);
                    *(f32x4*)(rowp + n * 16) = x; } }
    }
};
struct EpiAdd {
    static constexpr bool PERM = false, AFTER_DRAIN = false; float* X;
    __device__ __forceinline__ void operator()(const f32x4 (&acc)[2][2][4][2], const Unit& u, int wr, int wc, int fr, int fq) const {
        const int row0 = u.pm * 256 + wr * 64 + fr, col0 = u.pn * 256 + wc * 32 + 4 * fq;
#pragma unroll
        for (int ai = 0; ai < 2; ++ai)
#pragma unroll
            for (int m = 0; m < 4; ++m) { float* rowp = X + (size_t)(row0 + ai * 128 + m * 16) * D + col0;
#pragma unroll
                for (int bj = 0; bj < 2; ++bj)
#pragma unroll
                    for (int n = 0; n < 2; ++n) { f32x4 x = *(f32x4*)(rowp + bj * 128 + n * 16); x += acc[ai][bj][m][n]; *(f32x4*)(rowp + bj * 128 + n * 16) = x; } }
    }
};
struct TailOrder {
    int nN, S, kslice, G, c;
    __device__ bool next(int i, Unit& u) const { const int L = i * G + c; if (L >= 2 * nN * S) return false; u.pm = 128 + (L & 1); const int r = L >> 1; u.pn = r % nN; u.koff = (r / nN) * kslice; return true; }
    __device__ __forceinline__ void a_ready(const Unit&) const {}
    __device__ __forceinline__ void done(const Unit&) const {}
};
struct EpiPartial {
    static constexpr bool PERM = false, AFTER_DRAIN = false; float* Pp; int kslice;
    __device__ __forceinline__ void operator()(const f32x4 (&acc)[2][2][4][2], const Unit& u, int wr, int wc, int fr, int fq) const {
        const int row0 = (u.pm - 128) * 256 + wr * 64 + fr, col0 = u.pn * 256 + wc * 32 + 4 * fq, ks = u.koff / kslice;
#pragma unroll
        for (int ai = 0; ai < 2; ++ai)
#pragma unroll
            for (int m = 0; m < 4; ++m) { float* rowp = Pp + ((size_t)ks * MS + row0 + ai * 128 + m * 16) * D + col0;
#pragma unroll
                for (int bj = 0; bj < 2; ++bj)
#pragma unroll
                    for (int n = 0; n < 2; ++n) *(f32x4*)(rowp + bj * 128 + n * 16) = acc[ai][bj][m][n]; }
    }
};
struct EpiRelu2 {
    static constexpr bool PERM = true, AFTER_DRAIN = false; bf16_t* O;
    __device__ __forceinline__ void operator()(const f32x4 (&acc)[2][2][4][2], const Unit& u, int wr, int wc, int fr, int fq) const {
        const int row0 = u.pm * 256 + wr * 64 + fr, col0 = u.pn * 256 + wc * 32 + 8 * fq;
#pragma unroll
        for (int ai = 0; ai < 2; ++ai)
#pragma unroll
            for (int m = 0; m < 4; ++m) { bf16_t* rowp = O + (size_t)(row0 + ai * 128 + m * 16) * DFF + col0;
#pragma unroll
                for (int bj = 0; bj < 2; ++bj) { f32x4 v0 = acc[ai][bj][m][0], v1 = acc[ai][bj][m][1];
#pragma unroll
                    for (int j = 0; j < 4; ++j) { const float a = fmaxf(v0[j], 0.f), b = fmaxf(v1[j], 0.f); v0[j] = a * a; v1[j] = b * b; }
                    u32x4 w; w.x = cvt_pk_bf16(v0[0], v0[1]); w.y = cvt_pk_bf16(v0[2], v0[3]); w.z = cvt_pk_bf16(v1[0], v1[1]); w.w = cvt_pk_bf16(v1[2], v1[3]);
                    *(u32x4*)(rowp + bj * 128) = w; } }
    }
};
struct EpiSsdIn {
    static constexpr bool PERM = true, AFTER_DRAIN = false; bf16_t* O; float* DT;
    __device__ __forceinline__ void operator()(const f32x4 (&acc)[2][2][4][2], const Unit& u, int wr, int wc, int fr, int fq) const {
        const int row0 = u.pm * 256 + wr * 64 + fr;
        if (u.pn < 40) { const int col0 = u.pn * 256 + wc * 32 + 8 * fq;
#pragma unroll
            for (int ai = 0; ai < 2; ++ai)
#pragma unroll
                for (int m = 0; m < 4; ++m) { bf16_t* rowp = O + (size_t)(row0 + ai * 128 + m * 16) * ZXW + col0;
#pragma unroll
                    for (int bj = 0; bj < 2; ++bj) { const f32x4 v0 = acc[ai][bj][m][0], v1 = acc[ai][bj][m][1];
                        u32x4 w; w.x = cvt_pk_bf16(v0[0], v0[1]); w.y = cvt_pk_bf16(v0[2], v0[3]); w.z = cvt_pk_bf16(v1[0], v1[1]); w.w = cvt_pk_bf16(v1[2], v1[3]);
                        *(u32x4*)(rowp + bj * 128) = w; } }
        } else if (wc < 2) {
#pragma unroll
            for (int ai = 0; ai < 2; ++ai)
#pragma unroll
                for (int m = 0; m < 4; ++m) { float* rowp = DT + (size_t)(row0 + ai * 128 + m * 16) * 64 + wc * 32 + 8 * fq;
                    *(f32x4*)(rowp) = acc[ai][0][m][0]; *(f32x4*)(rowp + 4) = acc[ai][0][m][1]; }
        }
    }
};
__device__ __forceinline__ void s5_phase(const Params& P, int j, const bf16_t* U, bf16_t* G, lptr lds) {
    const int tid = threadIdx.x, wid = __builtin_amdgcn_readfirstlane(tid >> 6), lane = tid & 63, fr = lane & 15, fq = lane >> 4;
    lptr Ut = lds + wid * 8704; lptr Hm = Ut + 4096;
    const int nit = wid < 4 ? 1 : 4;
    for (int it = 0; it < nit; ++it) {
        int b, g, T; size_t row0; bool smp = wid >= 4;
        if (!smp) { const int item = blockIdx.x * 4 + wid; b = item >> 7; g = item & 127; T = 4096; row0 = (size_t)b * 4096; }
        else { const int item = (blockIdx.x * 4 + (wid - 4)) + 1024 * it; b = item >> 7; g = item & 127; T = 16; row0 = (size_t)MP + b * 16; }
        const int jg = j * 128 + g;
        const float lr = P.in[9][jg * 64 + lane], li = P.in[10][jg * 64 + lane], dt = expf(P.in[11][jg]);
        const float e = expf(lr * dt), lbr = e * cosf(li * dt), lbi = e * sinf(li * dt);
        const float nr = lbr - 1.0f, ni = lbi, den = 1.0f / (lr * lr + li * li), fre = (nr * lr + ni * li) * den, fim = (ni * lr - nr * li) * den;
        float Bre[16], Bim[16];
#pragma unroll
        for (int c4 = 0; c4 < 4; ++c4) { const f32x4 br = *(const f32x4*)(P.in[12] + ((size_t)jg * 64 + lane) * 16 + c4 * 4), bi = *(const f32x4*)(P.in[13] + ((size_t)jg * 64 + lane) * 16 + c4 * 4);
#pragma unroll
            for (int i = 0; i < 4; ++i) { Bre[c4 * 4 + i] = fre * br[i] - fim * bi[i]; Bim[c4 * 4 + i] = fre * bi[i] + fim * br[i]; } }
        f32x2v B2[16];
#pragma unroll
        for (int i = 0; i < 16; ++i) B2[i] = (f32x2v){Bre[i], Bim[i]};
        bf16x8 Cf[4];
#pragma unroll
        for (int kb = 0; kb < 4; ++kb) { const f32x4 cr = *(const f32x4*)(P.in[14] + ((size_t)jg * 16 + fr) * 64 + 16 * kb + 4 * fq), ci = *(const f32x4*)(P.in[15] + ((size_t)jg * 16 + fr) * 64 + 16 * kb + 4 * fq);
            u32x4 w; w.x = cvt_pk_bf16(cr[0], -ci[0]); w.y = cvt_pk_bf16(cr[1], -ci[1]); w.z = cvt_pk_bf16(cr[2], -ci[2]); w.w = cvt_pk_bf16(cr[3], -ci[3]); Cf[kb] = __builtin_bit_cast(bf16x8, w); }
        const f32x4 dsk = *(const f32x4*)(P.in[16] + (size_t)j * D + g * 16 + 4 * fq);
        float hre = 0.f, him = 0.f;
        if (smp) { hre = P.in[2][((size_t)(j * 32 + b) * 128 + g) * 64 + lane]; him = P.in[3][((size_t)(j * 32 + b) * 128 + g) * 64 + lane]; }
        u32x4 pfa = {0u, 0u, 0u, 0u}, pfc = pfa;
        if (lane < (T < 64 ? T : 64)) { const u32x4* up = (const u32x4*)(U + (row0 + lane) * D + g * 16); pfa = up[0]; pfc = up[1]; }
        for (int t0 = 0; t0 < T; t0 += 64) {
            const int ntk = (T - t0) < 64 ? (T - t0) : 64;
            const u32x4 a = pfa, c = pfc;
            if (t0 + 64 < T) { const u32x4* up = (const u32x4*)(U + (row0 + t0 + 64 + lane) * D + g * 16); pfa = up[0]; pfc = up[1]; }
            if (lane < ntk) {
                LAS f32x4* d = (LAS f32x4*)(Ut + lane * 64);
                d[0] = (f32x4){bflo(a.x), bfhi(a.x), bflo(a.y), bfhi(a.y)}; d[1] = (f32x4){bflo(a.z), bfhi(a.z), bflo(a.w), bfhi(a.w)};
                d[2] = (f32x4){bflo(c.x), bfhi(c.x), bflo(c.y), bfhi(c.y)}; d[3] = (f32x4){bflo(c.z), bfhi(c.z), bflo(c.w), bfhi(c.w)}; }
            LDS_FENCE();
            for (int tb = 0; tb < ntk; tb += 16) {
#pragma unroll 4
                for (int tt = 0; tt < 16; ++tt) {
                    const LAS f32x4* up = (const LAS f32x4*)(Ut + (tb + tt) * 64); const f32x4 u0 = up[0], u1 = up[1], u2 = up[2], u3 = up[3];
                    f32x2v bu0 = {0.f, 0.f}, bu1 = {0.f, 0.f};
#pragma unroll
                    for (int i = 0; i < 4; i += 2) { bu0 += B2[i] * u0[i]; bu1 += B2[i + 1] * u0[i + 1]; bu0 += B2[4 + i] * u1[i]; bu1 += B2[5 + i] * u1[i + 1]; bu0 += B2[8 + i] * u2[i]; bu1 += B2[9 + i] * u2[i + 1]; bu0 += B2[12 + i] * u3[i]; bu1 += B2[13 + i] * u3[i + 1]; }
                    const f32x2v hs = {-him, hre}, hh = {hre, him};
                    const f32x2v nh = hh * lbr + (hs * lbi + (bu0 + bu1)); hre = nh.x; him = nh.y;
                    *(LAS unsigned*)(Hm + tt * 272 + lane * 4) = cvt_pk_bf16(hre, him);
                }
                LDS_FENCE();
                f32x4 acc = {0.f, 0.f, 0.f, 0.f};
#pragma unroll
                for (int kb = 0; kb < 4; ++kb) { const bf16x8 hb = *(const LAS bf16x8*)(Hm + fr * 272 + (32 * kb + 8 * fq) * 2); acc = __builtin_amdgcn_mfma_f32_16x16x32_bf16(Cf[kb], hb, acc, 0, 0, 0); }
                const f32x4 uu = *(const LAS f32x4*)(Ut + (tb + fr) * 64 + fq * 16);
                float y[4];
#pragma unroll
                for (int i = 0; i < 4; ++i) { const float v = acc[i] + dsk[i] * uu[i]; const float z2 = 1.5957691216f * (v + 0.044715f * v * v * v); y[i] = v * sigmoidf_(z2); }
                u32x2 w; w.x = cvt_pk_bf16(y[0], y[1]); w.y = cvt_pk_bf16(y[2], y[3]);
                *(u32x2*)(G + (row0 + t0 + tb + fr) * D + g * 16 + 4 * fq) = w;
                LDS_FENCE();
            }
        }
        const size_t so = smp ? ((size_t)(j * 32 + b) * 128 + g) * 64 + lane : ((size_t)(j * 8 + b) * 128 + g) * 64 + lane;
        P.out[(smp ? O_S5RS : O_S5RP) + so] = hre; P.out[(smp ? O_S5IS : O_S5IP) + so] = him;
    }
}

constexpr int L_BS = 0, L_CS = 17408, L_BST = 34816, L_HALF = 53248, HALF_BYTES = 36352, LH_XT = 0, LH_W = 9216, LH_HS = 18432, LH_AC = 35840, LH_DT = 36096;
__device__ __forceinline__ bf16x8 scale8(bf16x8 v, const float* t) { u32x4 w = __builtin_bit_cast(u32x4, v); u32x4 o;
    o.x = cvt_pk_bf16(bflo(w.x) * t[0], bfhi(w.x) * t[1]); o.y = cvt_pk_bf16(bflo(w.y) * t[2], bfhi(w.y) * t[3]); o.z = cvt_pk_bf16(bflo(w.z) * t[4], bfhi(w.z) * t[5]); o.w = cvt_pk_bf16(bflo(w.w) * t[6], bfhi(w.w) * t[7]);
    return __builtin_bit_cast(bf16x8, o); }
__device__ __forceinline__ void ssd_phase(const Params& P, int jj, const bf16_t* ZX, const float* DTb, bf16_t* Yg, lptr lds) {
    const int tid = threadIdx.x, wid = __builtin_amdgcn_readfirstlane(tid >> 6), lane = tid & 63, j = lane & 15, q = lane >> 4, hb = wid >> 2, wv = wid & 3;
    lptr Bs = lds + L_BS, Cs = lds + L_CS, Bst = lds + L_BST, Hf = lds + L_HALF + hb * HALF_BYTES, Xt = Hf + LH_XT, Wl = Hf + LH_W, Hs = Hf + LH_HS;
    LAS float* acs = (LAS float*)(Hf + LH_AC); LAS float* dts = (LAS float*)(Hf + LH_DT);
    for (int it = 0; it < 5; ++it) {
        const bool smp = it > 0; int b, hp, T, nsteps; size_t rowb;
        if (!smp) { b = blockIdx.x >> 5; hp = blockIdx.x & 31; T = 64; nsteps = 64; rowb = (size_t)b * 4096; }
        else { const int id = blockIdx.x * 4 + (it - 1); b = id >> 5; hp = id & 31; T = 16; nsteps = 1; rowb = (size_t)MP + b * 16; }
        const int g = hp >> 2, h = 2 * hp + hb;
        const int o = tid % 48, seg = tid / 48; const bool cact = tid < 384; int zcol, ch, kind, sub;
        if (o < 16) { kind = 0; sub = o >> 3; ch = (2 * hp + sub) * 64 + (o & 7) * 8; } else if (o < 32) { kind = 1; sub = 0; ch = 4096 + g * 128 + (o - 16) * 8; } else { kind = 2; sub = 0; ch = 5120 + g * 128 + (o - 32) * 8; }
        zcol = 4096 + ch;
        const float dtb = P.in[21][jj * 64 + h], aneg = -expf(P.in[22][jj * 64 + h]), dsk = P.in[23][jj * 64 + h];
        LAS float* cwl = (LAS float*)(lds + 132096);
        if (tid < 48) {
#pragma unroll
            for (int hf = 0; hf < 2; ++hf) { LAS f32x4* d = (LAS f32x4*)(cwl + (o * 2 + hf) * 20);
#pragma unroll
                for (int k = 0; k < 4; ++k) d[k] = *(const f32x4*)(P.in[19] + ((size_t)jj * 4 + k) * CONVD + ch + hf * 4);
                d[4] = *(const f32x4*)(P.in[20] + (size_t)jj * CONVD + ch + hf * 4); } }
#define SSD_LOAD_RAW(stepv) do { const size_t Rn_ = rowb + (size_t)(stepv) * 64; \
    _Pragma("unroll") for (int hf = 0; hf < 2; ++hf) _Pragma("unroll") for (int i = 0; i < 11; ++i) { const int l_ = seg * 8 + i - 3; u32x2 v_ = {0u, 0u}; \
        if (l_ < T) { if (l_ >= 0 || (stepv) > 0) v_ = *(const u32x2*)(ZX + (Rn_ + l_) * ZXW + zcol + hf * 4); \
            else if (smp) { const f32x4 a_ = *(const f32x4*)(P.in[4] + (((size_t)jj * 32 + b) * 3 + (l_ + 3)) * CONVD + ch + hf * 4); v_.x = cvt_pk_bf16(a_[0], a_[1]); v_.y = cvt_pk_bf16(a_[2], a_[3]); } } \
        raw[hf][i] = v_; } } while (0)
        float dtn = 0.f; if (wv == 0 && lane < T) dtn = DTb[(rowb + lane) * 64 + h];
        __syncthreads();
        f32x4 st[2][4];
#pragma unroll
        for (int nt2 = 0; nt2 < 2; ++nt2)
#pragma unroll
            for (int pt = 0; pt < 4; ++pt) {
                st[nt2][pt] = smp ? *(const f32x4*)(P.in[5] + ((((size_t)jj * 32 + b) * 64 + h) * 64 + 16 * pt + j) * 128 + 16 * (2 * wv + nt2) + 4 * q) : (f32x4){0.f, 0.f, 0.f, 0.f};
                u32x2 w; w.x = cvt_pk_bf16(st[nt2][pt][0], st[nt2][pt][1]); w.y = cvt_pk_bf16(st[nt2][pt][2], st[nt2][pt][3]);
                *(LAS u32x2*)(Hs + (16 * pt + j) * 272 + (16 * (2 * wv + nt2) + 4 * q) * 2) = w; }
        for (int step = 0; step < nsteps; ++step) {
            const size_t R = rowb + (size_t)step * 64;
            if (wv == 0) { float dtv = 0.f; if (lane < T) { const float x = dtn + dtb; dtv = x > 20.f ? x : log1pf(__expf(x)); }
                float cs = dtv * aneg;
#pragma unroll
                for (int o2 = 1; o2 < 64; o2 <<= 1) { const float t = __shfl_up(cs, o2); if (lane >= o2) cs += t; }
                acs[lane] = cs; dts[lane] = dtv; }
            if (cact) {
#pragma unroll 1
              for (int hf = 0; hf < 2; ++hf) {
                const int ch4 = ch + hf * 4;
                u32x2 raw[11];
#pragma unroll
                for (int i = 0; i < 11; ++i) { const int l_ = seg * 8 + i - 3; u32x2 v_ = {0u, 0u};
                    if (l_ < T) { if (l_ >= 0 || step > 0) v_ = *(const u32x2*)(ZX + (R + l_) * ZXW + zcol + hf * 4);
                        else if (smp) { const f32x4 a_ = *(const f32x4*)(P.in[4] + (((size_t)jj * 32 + b) * 3 + (l_ + 3)) * CONVD + ch4); v_.x = cvt_pk_bf16(a_[0], a_[1]); v_.y = cvt_pk_bf16(a_[2], a_[3]); } }
                    raw[i] = v_; }
                float cw[4][4], cb[4];
                { const LAS f32x4* wp = (const LAS f32x4*)(cwl + (o * 2 + hf) * 20);
#pragma unroll
                  for (int k = 0; k < 4; ++k) { const f32x4 a = wp[k];
#pragma unroll
                    for (int i = 0; i < 4; ++i) cw[k][i] = a[i]; }
                  const f32x4 a = wp[4];
#pragma unroll
                  for (int i = 0; i < 4; ++i) cb[i] = a[i]; }
                unsigned tp[4][4];
#pragma unroll
                for (int r = 0; r < 8; r += 2) {
                    float o0[4], o1[4];
#pragma unroll
                    for (int c = 0; c < 4; ++c) { o0[c] = cb[c]; o1[c] = cb[c]; }
#pragma unroll
                    for (int k = 0; k < 4; ++k) { const u32x2 a = raw[r + k], c2 = raw[r + 1 + k];
                        const float xa[4] = {bflo(a.x), bfhi(a.x), bflo(a.y), bfhi(a.y)};
                        const float xc[4] = {bflo(c2.x), bfhi(c2.x), bflo(c2.y), bfhi(c2.y)};
#pragma unroll
                        for (int c = 0; c < 4; ++c) { o0[c] += cw[k][c] * xa[c]; o1[c] += cw[k][c] * xc[c]; } }
                    const bool v0 = (seg * 8 + r) < T, v1 = (seg * 8 + r + 1) < T;
#pragma unroll
                    for (int c = 0; c < 4; ++c) { o0[c] = v0 ? o0[c] * sigmoidf_(o0[c]) : 0.f; o1[c] = v1 ? o1[c] * sigmoidf_(o1[c]) : 0.f; tp[c][r >> 1] = cvt_pk_bf16(o0[c], o1[c]); }
                    if (kind != 0) { lptr dst = (kind == 1 ? Bs : Cs) + (seg * 8 + r) * 272 + (ch4 & 127) * 2;
                        u32x2 w0, w1; w0.x = cvt_pk_bf16(o0[0], o0[1]); w0.y = cvt_pk_bf16(o0[2], o0[3]); w1.x = cvt_pk_bf16(o1[0], o1[1]); w1.y = cvt_pk_bf16(o1[2], o1[3]);
                        *(LAS u32x2*)dst = w0; *(LAS u32x2*)(dst + 272) = w1; }
                }
                if (kind != 2) { lptr dst = (kind == 0 ? (lds + L_HALF + sub * HALF_BYTES + LH_XT) + (ch4 & 63) * 144 : Bst + (ch4 & 127) * 144) + seg * 16;
#pragma unroll
                    for (int c = 0; c < 4; ++c) { u32x4 w; w.x = tp[c][0]; w.y = tp[c][1]; w.z = tp[c][2]; w.w = tp[c][3]; *(LAS u32x4*)(dst + c * 144) = w; } }
              }
            }
            __syncthreads();
            if (step + 1 < nsteps) { if (wv == 0) dtn = DTb[(R + 64 + lane) * 64 + h]; }
            u32x2 zz4[4];
            { const int l0 = 16 * wv + j, lz = l0 < T ? l0 : 0;
#pragma unroll
              for (int pt = 0; pt < 4; ++pt) zz4[pt] = *(const u32x2*)(ZX + (R + lz) * ZXW + h * 64 + 16 * pt + 4 * q); }
            const int l = 16 * wv + j; const float acl = acs[l], ac63 = acs[63];
            bf16x8 Cf[4];
#pragma unroll
            for (int kb = 0; kb < 4; ++kb) Cf[kb] = *(const LAS bf16x8*)(Cs + l * 272 + (32 * kb + 8 * q) * 2);
#pragma unroll
            for (int s4 = 0; s4 < 4; ++s4) { f32x4 a4 = {0.f, 0.f, 0.f, 0.f};
                if (s4 <= wv) {
#pragma unroll
                    for (int kb = 0; kb < 4; ++kb) { const bf16x8 bf = *(const LAS bf16x8*)(Bs + (16 * s4 + j) * 272 + (32 * kb + 8 * q) * 2); a4 = __builtin_amdgcn_mfma_f32_16x16x32_bf16(bf, Cf[kb], a4, 0, 0, 0); }
                    const f32x4 as = *(const LAS f32x4*)(acs + 16 * s4 + 4 * q), ds = *(const LAS f32x4*)(dts + 16 * s4 + 4 * q);
#pragma unroll
                    for (int i = 0; i < 4; ++i) { const int s = 16 * s4 + 4 * q + i; a4[i] = (s <= l) ? a4[i] * __expf(acl - as[i]) * ds[i] : 0.f; } }
                u32x2 w; w.x = cvt_pk_bf16(a4[0], a4[1]); w.y = cvt_pk_bf16(a4[2], a4[3]);
                *(LAS u32x2*)(Wl + l * 144 + (16 * s4 + 4 * q) * 2) = w; }
            LDS_FENCE();
            f32x4 Ya[4];
            { const float el = __expf(acl);
#pragma unroll
              for (int pt = 0; pt < 4; ++pt) { f32x4 yi = {0.f, 0.f, 0.f, 0.f};
#pragma unroll
                for (int kb = 0; kb < 4; ++kb) { const bf16x8 hf = *(const LAS bf16x8*)(Hs + (16 * pt + j) * 272 + (32 * kb + 8 * q) * 2); yi = __builtin_amdgcn_mfma_f32_16x16x32_bf16(hf, Cf[kb], yi, 0, 0, 0); }
                Ya[pt] = yi * el; } }
#pragma unroll
            for (int kb = 0; kb < 2; ++kb) { const bf16x8 wf = *(const LAS bf16x8*)(Wl + l * 144 + (32 * kb + 8 * q) * 2);
#pragma unroll
                for (int pt = 0; pt < 4; ++pt) { const bf16x8 xf = *(const LAS bf16x8*)(Xt + (16 * pt + j) * 144 + (32 * kb + 8 * q) * 2); Ya[pt] = __builtin_amdgcn_mfma_f32_16x16x32_bf16(xf, wf, Ya[pt], 0, 0, 0); } }
            if (l < T) {
#pragma unroll
                for (int pt = 0; pt < 4; ++pt) { const int p0 = 16 * pt + 4 * q; const u32x2 zz = zz4[pt];
                    const float zf[4] = {bflo(zz.x), bfhi(zz.x), bflo(zz.y), bfhi(zz.y)}; float y[4];
#pragma unroll
                    for (int i = 0; i < 4; ++i) { const float xv = __uint_as_float((unsigned)(*(const LAS unsigned short*)(Xt + (p0 + i) * 144 + l * 2)) << 16); y[i] = (Ya[pt][i] + dsk * xv) * zf[i] * sigmoidf_(zf[i]); }
                    u32x2 w; w.x = cvt_pk_bf16(y[0], y[1]); w.y = cvt_pk_bf16(y[2], y[3]); *(u32x2*)(Yg + (R + l) * DIN + h * 64 + p0) = w; }
            }
            { const float dec = __expf(ac63);
#pragma unroll
              for (int nt2 = 0; nt2 < 2; ++nt2)
#pragma unroll
                for (int pt = 0; pt < 4; ++pt) st[nt2][pt] *= dec;
#pragma unroll
              for (int kb = 0; kb < 2; ++kb) { float tl[8]; const f32x4 a0 = *(const LAS f32x4*)(acs + 32 * kb + 8 * q), a1 = *(const LAS f32x4*)(acs + 32 * kb + 8 * q + 4), d0 = *(const LAS f32x4*)(dts + 32 * kb + 8 * q), d1 = *(const LAS f32x4*)(dts + 32 * kb + 8 * q + 4);
#pragma unroll
                for (int i = 0; i < 4; ++i) { tl[i] = __expf(ac63 - a0[i]) * d0[i]; tl[4 + i] = __expf(ac63 - a1[i]) * d1[i]; }
                bf16x8 bfr[2];
#pragma unroll
                for (int nt2 = 0; nt2 < 2; ++nt2) bfr[nt2] = *(const LAS bf16x8*)(Bst + (16 * (2 * wv + nt2) + j) * 144 + (32 * kb + 8 * q) * 2);
#pragma unroll
                for (int pt = 0; pt < 4; ++pt) { const bf16x8 xs = scale8(*(const LAS bf16x8*)(Xt + (16 * pt + j) * 144 + (32 * kb + 8 * q) * 2), tl);
#pragma unroll
                    for (int nt2 = 0; nt2 < 2; ++nt2) st[nt2][pt] = __builtin_amdgcn_mfma_f32_16x16x32_bf16(bfr[nt2], xs, st[nt2][pt], 0, 0, 0); } } }
            __syncthreads();
#pragma unroll
            for (int nt2 = 0; nt2 < 2; ++nt2)
#pragma unroll
                for (int pt = 0; pt < 4; ++pt) { u32x2 w; w.x = cvt_pk_bf16(st[nt2][pt][0], st[nt2][pt][1]); w.y = cvt_pk_bf16(st[nt2][pt][2], st[nt2][pt][3]);
                    *(LAS u32x2*)(Hs + (16 * pt + j) * 272 + (16 * (2 * wv + nt2) + 4 * q) * 2) = w; }
        }
        float* so = P.out + (smp ? O_SSMS + (((size_t)jj * 32 + b) * 64 + h) * 8192 : O_SSMP + (((size_t)jj * 8 + b) * 64 + h) * 8192);
#pragma unroll
        for (int nt2 = 0; nt2 < 2; ++nt2)
#pragma unroll
            for (int pt = 0; pt < 4; ++pt) *(f32x4*)(so + (16 * pt + j) * 128 + 16 * (2 * wv + nt2) + 4 * q) = st[nt2][pt];
        __syncthreads();
#undef SSD_LOAD_RAW
    }
}
__device__ __forceinline__ void gnorm_phase(const Params& P, int jj, bf16_t* Yg, const bf16_t* ZX) {
    const int lane = threadIdx.x & 63, gw = blockIdx.x * 8 + (threadIdx.x >> 6), nW = gridDim.x * 8;
    for (int idx = gw; idx < M * 8; idx += nW) {
        const int row = idx >> 3, gi = idx & 7; bf16_t* p = Yg + (size_t)row * DIN + gi * 512 + lane * 8;
        const u32x4 v = *(const u32x4*)p; float f[8] = {bflo(v.x), bfhi(v.x), bflo(v.y), bfhi(v.y), bflo(v.z), bfhi(v.z), bflo(v.w), bfhi(v.w)};
        float ss = 0.f;
#pragma unroll
        for (int i = 0; i < 8; ++i) ss += f[i] * f[i];
        ss = wave_sum(ss); const float r = __builtin_amdgcn_rsqf(ss * (1.0f / 512.0f) + EPS);
        const float* nw = P.in[24] + (size_t)jj * DIN + gi * 512 + lane * 8; const f32x4 w0 = *(const f32x4*)nw, w1 = *(const f32x4*)(nw + 4);
        u32x4 o; o.x = cvt_pk_bf16(f[0] * r * w0[0], f[1] * r * w0[1]); o.y = cvt_pk_bf16(f[2] * r * w0[2], f[3] * r * w0[3]); o.z = cvt_pk_bf16(f[4] * r * w1[0], f[5] * r * w1[1]); o.w = cvt_pk_bf16(f[6] * r * w1[2], f[7] * r * w1[3]);
        *(u32x4*)p = o;
    }
    const int gt = blockIdx.x * 512 + threadIdx.x, nTh = gridDim.x * 512;
    for (int e = gt; e < 40 * 3 * CONVD; e += nTh) {
        const int ch = e % CONVD, r = (e / CONVD) % 3, bb = e / (3 * CONVD);
        const size_t row = bb < 8 ? (size_t)bb * 4096 + 4093 + r : (size_t)MP + (bb - 8) * 16 + 13 + r;
        const float v = __uint_as_float((unsigned)ZX[row * ZXW + 4096 + ch] << 16);
        if (bb < 8) P.out[O_CONVP + (((size_t)jj * 8 + bb) * 3 + r) * CONVD + ch] = v; else P.out[O_CONVS + (((size_t)jj * 32 + (bb - 8)) * 3 + r) * CONVD + ch] = v;
    }
}

__global__ void __launch_bounds__(512, 2) fwd(Params P) {
    extern __shared__ __attribute__((aligned(16))) unsigned char shm[];
    lptr lds = (lptr)shm;
    if (threadIdx.x < 4) ((LAS unsigned*)(lds + LDS_BAR))[threadIdx.x] = 0u;
    __syncthreads();
    const int lo = P.ph_lo, hi = P.ph_hi;
    unsigned char* ws = P.ws;
    XcdBarrier bar; bar.bar = (unsigned*)(ws + WS_CTL); bar.x = 0; bar.st = (volatile LAS unsigned*)(lds + LDS_BAR);
    if (hi - lo > 1) bar = xcd_barrier_post((unsigned*)(ws + WS_CTL), (volatile LAS unsigned*)(lds + LDS_BAR));
    float* X = P.out;
    bf16_t* A = (bf16_t*)(ws + WS_R1); bf16_t* G2 = A + (size_t)M * D; bf16_t* R2 = (bf16_t*)(ws + WS_R2); float* DTb = (float*)(ws + WS_DT);
    float* PART = (float*)(ws + WS_PART); bf16_t* WA = (bf16_t*)(ws + WS_WA); bf16_t* WB = (bf16_t*)(ws + WS_WB); bf16_t* W1 = (bf16_t*)(ws + WS_W1); bf16_t* W2 = (bf16_t*)(ws + WS_W2);
    const int G = gridDim.x, c = blockIdx.x;
#define RUN(k) (lo <= (k) && (k) < hi)
#define SEAM(k) do { if ((k) + 1 < hi) xcd_barrier(bar); } while (0)
#ifdef NO_S5
#define S5_CALL
#else
#define S5_CALL s5_phase(P, jx, A, G2, lds)
#endif
#ifdef NO_SSD
#define SSD_CALL
#else
#define SSD_CALL ssd_phase(P, jx, R2, DTb, A, lds)
#endif
#define LAYER(i) { \
        const int jx = i >> 1, pb = i * 8; \
        if ((i & 1) == 0) { \
            if (RUN(pb + 0)) { \
                convert_wt(P.in[17] + (size_t)jx * D * 4096, D, 4096, WA, 4096, 1, lds); \
                convert_wt(P.in[26] + (size_t)i * D * DFF, D, DFF, W1, DFF, 0, lds); \
                convert_wt(P.in[27] + (size_t)i * DFF * D, DFF, D, W2, D, 0, lds); \
                if (i == 0) rms_phase<1>(P.in[0], P.in[1], X, P.in[6] + (size_t)i * D, A); else rms_phase<0>(nullptr, nullptr, X, P.in[6] + (size_t)i * D, A, PART); \
                SEAM(pb + 0); } \
            if (RUN(pb + 1)) { \
 S5_CALL; \
 SEAM(pb + 1); } \
            if (RUN(pb + 2)) { pg8::Gemm g{G2, WA, M, 4096, D}; pg8::StaticOrder S; S.init(M, 4096, G, c); EpiGlu E{X, i == 0 ? P.in[0] : X, i == 0 ? P.in[1] : X + (size_t)MP * D}; pg8::gemm_phase<EpiGlu, pg8::StaticOrder, false>(lds, g, S, E, nullptr); SEAM(pb + 2); } \
        } else { \
            if (RUN(pb + 0)) { \
                convert_wt(P.in[18] + (size_t)jx * D * NPROJ, D, NPROJ, WA, NPROJ_PAD, 2, lds); \
                convert_wt(P.in[25] + (size_t)jx * DIN * D, DIN, D, WB, D, 0, lds); \
                convert_wt(P.in[26] + (size_t)i * D * DFF, D, DFF, W1, DFF, 0, lds); \
                convert_wt(P.in[27] + (size_t)i * DFF * D, DFF, D, W2, D, 0, lds); \
                rms_phase<0>(nullptr, nullptr, X, P.in[6] + (size_t)i * D, A, PART); \
                SEAM(pb + 0); } \
            if (RUN(pb + 1)) { pg8::Gemm g{A, WA, M, NPROJ_PAD, D}; pg8::StaticOrder S; S.init(M, NPROJ_PAD, G, c); EpiSsdIn E{R2, DTb}; pg8::gemm_phase<EpiSsdIn, pg8::StaticOrder, false>(lds, g, S, E, nullptr); SEAM(pb + 1); } \
            if (RUN(pb + 2)) { \
 SSD_CALL; \
 SEAM(pb + 2); } \
            if (RUN(pb + 3)) { gnorm_phase(P, jx, A, R2); SEAM(pb + 3); } \
            if (RUN(pb + 4)) { { pg8::Gemm g{A, WB, MP, D, DIN, DIN}; pg8::StaticOrder S; S.init(MP, D, G, c); EpiAdd E{X}; pg8::gemm_phase<EpiAdd, pg8::StaticOrder, false>(lds, g, S, E, nullptr); } { pg8::Gemm g{A, WB, M, D, DIN / 16, DIN}; TailOrder S{8, 16, DIN / 16, G, c}; EpiPartial E{PART, DIN / 16}; pg8::gemm_phase<EpiPartial, TailOrder, false>(lds, g, S, E, nullptr); } SEAM(pb + 4); } \
        } \
        if (RUN(pb + 5)) { rms_phase<0>(nullptr, nullptr, X, P.in[7] + (size_t)i * D, A, (i & 1) ? PART : nullptr); SEAM(pb + 5); } \
        if (RUN(pb + 6)) { pg8::Gemm g{A, W1, M, DFF, D}; pg8::StaticOrder S; S.init(M, DFF, G, c); EpiRelu2 E{R2}; pg8::gemm_phase<EpiRelu2, pg8::StaticOrder, false>(lds, g, S, E, nullptr); SEAM(pb + 6); } \
        if (RUN(pb + 7)) { { pg8::Gemm g{R2, W2, MP, D, DFF, DFF}; pg8::StaticOrder S; S.init(MP, D, G, c); EpiAdd E{X}; pg8::gemm_phase<EpiAdd, pg8::StaticOrder, false>(lds, g, S, E, nullptr); } { pg8::Gemm g{R2, W2, M, D, DFF / 16, DFF}; TailOrder S{8, 16, DFF / 16, G, c}; EpiPartial E{PART, DFF / 16}; pg8::gemm_phase<EpiPartial, TailOrder, false>(lds, g, S, E, nullptr); } SEAM(pb + 7); } \
}
    LAYER(0) LAYER(1) LAYER(2) LAYER(3)
    if (RUN(32)) rms_phase<2>(nullptr, nullptr, X, P.in[8], nullptr, PART);
}

#ifndef BISECT
#define BISECT 0
#endif
#ifndef N_LAUNCH_PER_PHASE
#define N_LAUNCH_PER_PHASE 0
#endif
extern "C" void kernel_launch(void* const* d_in, const int* in_sizes, int n_in, void* d_out, int out_size, void* d_ws, size_t ws_size, hipStream_t stream) {
    static int grid = 0;
    if (grid == 0) {
        if (n_in != 28 || ws_size < WS_END) { fprintf(stderr, "kernel_launch: need 28 inputs and %zu bytes of workspace; got %d, %zu\n", (size_t)WS_END, n_in, ws_size); grid = -1; return; }
        int dev = 0, cus = 0, per_cu = 0;
        if (hipGetDevice(&dev) != hipSuccess || hipDeviceGetAttribute(&cus, hipDeviceAttributeMultiprocessorCount, dev) != hipSuccess) { grid = -1; return; }
        if (hipFuncSetAttribute((const void*)fwd, hipFuncAttributeMaxDynamicSharedMemorySize, LDS_BYTES) != hipSuccess) { fprintf(stderr, "kernel_launch: hipFuncSetAttribute failed\n"); grid = -1; return; }
        if (hipOccupancyMaxActiveBlocksPerMultiprocessor(&per_cu, (const void*)fwd, 512, LDS_BYTES) != hipSuccess || per_cu < 1) fprintf(stderr, "kernel_launch: occupancy query says %d\n", per_cu);
        (void)hipGetLastError();
        grid = cus < 256 ? cus : 256;
    }
    if (grid < 0) return;
    (void)hipMemsetAsync((char*)d_ws + WS_CTL, 0, 16384, stream);
    Params p{};
    for (int i = 0; i < 28; ++i) p.in[i] = (const float*)d_in[i];
    p.out = (float*)d_out; p.ws = (unsigned char*)d_ws;
#if N_LAUNCH_PER_PHASE
    for (int k = 0; k <= 32; ++k) { const int s = k & 7; if (k < 32 && (((k >> 3) & 1) == 0) && (s == 3 || s == 4)) continue;
#if BISECT == 1
        if (k < 32 && (((k >> 3) & 1) == 1) && s >= 1 && s <= 4) continue;
#elif BISECT == 3
        if (k < 32 && (((k >> 3) & 1) == 1) && s >= 2 && s <= 3) continue;
#elif BISECT == 4
        if (k < 32 && (((k >> 3) & 1) == 1) && s == 3) continue;
#elif BISECT == 2
        if (k < 32 && (((k >> 3) & 1) == 0) && s >= 1 && s <= 2) continue;
#endif
 p.ph_lo = k; p.ph_hi = k + 1; hipLaunchKernelGGL(fwd, dim3(grid), dim3(512), LDS_BYTES, stream, p); }
#else
    p.ph_lo = 0; p.ph_hi = 33;
    hipLaunchKernelGGL(fwd, dim3(grid), dim3(512), LDS_BYTES, stream, p);
#endif
    const hipError_t le = hipPeekAtLastError();
    if (le != hipSuccess) fprintf(stderr, "kernel_launch: launch failed: %s\n", hipGetErrorName(le));
}
```
